# Optimizing an MI355X kernel written in HIP

```python
import math
import jax, jax.numpy as jnp
from jax import lax
import numpy as np

D_MODEL = 1024
BATCH = 1
SEQ = 16384
DEPTH = 4

GRID_W = 64
CTX_LEN = 256
N_MIXERS = 3
NORM_EPS = 1e-6
ROPE_THETA = 10000.0
Q_BLOCK = 128

A_HEADS = 8
A_HEAD_DIM = 64
A_WIDTH = A_HEADS * 2 * A_HEAD_DIM
B_HEADS = 16
B_HEAD_DIM = 64
B_WIDTH = B_HEADS * B_HEAD_DIM
NA_KH = 8
NA_KW = 16
NA_ROW_BLOCK = 2
C_HEADS = 16
C_KV_HEADS = 4
C_GROUP = C_HEADS // C_KV_HEADS
C_HEAD_DIM = 64
C_WINDOW = 128
C_QKV = C_HEADS * C_HEAD_DIM + 2 * C_KV_HEADS * C_HEAD_DIM
FFN_HIDDEN = ((8 * D_MODEL + 3 * 256 - 1) // (3 * 256)) * 256
N_A = (DEPTH + 2) // 3
N_B = (DEPTH + 1) // 3
N_C = DEPTH // 3

kernel_name = "hybrid_diff_na_swa_dit_trunk"


def rmsnorm(x, g):
    xf = x.astype(jnp.float32)
    y = xf * lax.rsqrt(jnp.mean(xf * xf, axis=-1, keepdims=True) + NORM_EPS)
    return (y * g.astype(jnp.float32)).astype(x.dtype)


def grid_angles(n_tok, rot_dim):
    half = rot_dim // 2
    freqs = ROPE_THETA ** (-jnp.arange(0, half, 2, dtype=jnp.float32) / half)
    pos = jnp.arange(n_tok)
    rows = (pos // GRID_W).astype(jnp.float32)
    cols = (pos % GRID_W).astype(jnp.float32)
    return rows[:, None] * freqs, cols[:, None] * freqs


def rotate(x, ang):
    cos = jnp.cos(ang)[:, None, :].astype(x.dtype)
    sin = jnp.sin(ang)[:, None, :].astype(x.dtype)
    x1, x2 = jnp.split(x, 2, axis=-1)
    return jnp.concatenate([x1 * cos - x2 * sin, x2 * cos + x1 * sin], axis=-1)


def rope_2d(x, ang_row, ang_col):
    xr, xc = jnp.split(x, 2, axis=-1)
    return jnp.concatenate([rotate(xr, ang_row), rotate(xc, ang_col)], axis=-1)


def diff_attention(h_lat, h_ctx, wqkv, wo, lam, subln, lam_init, ang, with_ctx_out):
    B, S, _ = h_lat.shape
    H, d = A_HEADS, A_HEAD_DIM
    scale = d ** -0.5

    def project(h):
        n = h.shape[1]
        q, k, v = jnp.split(h @ wqkv, 3, axis=-1)
        return q.reshape(B, n, H, 2, d), k.reshape(B, n, H, 2, d), v.reshape(B, n, H, 2 * d)

    q, k, v = project(h_lat)
    qc, kc, vc = project(h_ctx)
    q = rope_2d(q.reshape(B, S, 2 * H, d), *ang).reshape(B, S, H, 2, d) * scale
    k = rope_2d(k.reshape(B, S, 2 * H, d), *ang).reshape(B, S, H, 2, d)
    lam_full = (jnp.exp(jnp.sum(lam[0] * lam[1])) - jnp.exp(jnp.sum(lam[2] * lam[3])) + lam_init).astype(jnp.float32)

    def attend(qb, kk, vv):
        s = jnp.einsum('bqhmd,bkhmd->bhmqk', qb, kk).astype(jnp.float32)
        p = jax.nn.softmax(s, axis=-1)
        a = (p[:, :, 0] - lam_full * p[:, :, 1]).astype(vv.dtype)
        return jnp.einsum('bhqk,bkhe->bqhe', a, vv)

    def finish(o):
        n = o.shape[1]
        return (rmsnorm(o, subln) * (1.0 - lam_init)).reshape(B, n, A_WIDTH) @ wo

    keys = jnp.concatenate([kc, k], axis=1)
    vals = jnp.concatenate([vc, v], axis=1)
    nb = S // Q_BLOCK
    qblk = q.reshape(B, nb, Q_BLOCK, H, 2, d).swapaxes(0, 1)
    o = lax.map(lambda qb: attend(qb, keys, vals), qblk)
    y_lat = finish(o.swapaxes(0, 1).reshape(B, S, H, 2 * d))
    y_ctx = finish(attend(qc * scale, kc, vc)) if with_ctx_out else None
    return y_lat, y_ctx


def neighbourhood_attention(h_lat, h_ctx, wqkv, wo, rpb, with_ctx_out):
    B, S, _ = h_lat.shape
    H, d = B_HEADS, B_HEAD_DIM
    scale = d ** -0.5
    rows = S // GRID_W
    kh = min(NA_KH, rows)
    kw = NA_KW

    def project(h):
        n = h.shape[1]
        q, k, v = jnp.split(h @ wqkv, 3, axis=-1)
        return q.reshape(B, n, H, d), k.reshape(B, n, H, d), v.reshape(B, n, H, d)

    q, k, v = project(h_lat)
    qc, kc, vc = project(h_ctx)
    q = q * scale

    r = jnp.arange(rows)
    cg = jnp.arange(GRID_W)
    krow = jnp.clip(r - kh // 2, 0, rows - kh)[:, None] + jnp.arange(kh)
    kcol = jnp.clip(cg - kw // 2, 0, GRID_W - kw)[:, None] + jnp.arange(kw)
    nk = kh * kw
    nbr = (krow[:, None, :, None] * GRID_W + kcol[None, :, None, :]).reshape(S, nk)
    drow = krow - r[:, None] + (NA_KH - 1)
    dcol = kcol - cg[:, None] + (NA_KW - 1)
    rel = (drow[:, None, :, None] * (2 * NA_KW - 1) + dcol[None, :, None, :]).reshape(S, nk)
    rpb_flat = rpb.reshape(H, -1).astype(jnp.float32)

    qb_len = NA_ROW_BLOCK * GRID_W
    nb = rows // NA_ROW_BLOCK

    def block(args):
        qb, idx, rl = args
        kg = jnp.take(k, idx, axis=1)
        vg = jnp.take(v, idx, axis=1)
        s_nb = jnp.einsum('bqhd,bqnhd->bhqn', qb, kg).astype(jnp.float32) + rpb_flat[:, rl]
        s_cx = jnp.einsum('bqhd,bkhd->bhqk', qb, kc).astype(jnp.float32)
        p = jax.nn.softmax(jnp.concatenate([s_nb, s_cx], axis=-1), axis=-1).astype(v.dtype)
        return (jnp.einsum('bhqn,bqnhd->bqhd', p[..., :nk], vg)
                + jnp.einsum('bhqk,bkhd->bqhd', p[..., nk:], vc))

    qblk = q.reshape(B, nb, qb_len, H, d).swapaxes(0, 1)
    o = lax.map(block, (qblk, nbr.reshape(nb, qb_len, nk), rel.reshape(nb, qb_len, nk)))
    y_lat = o.swapaxes(0, 1).reshape(B, S, B_WIDTH) @ wo
    y_ctx = None
    if with_ctx_out:
        s = jnp.einsum('bqhd,bkhd->bhqk', qc * scale, kc).astype(jnp.float32)
        p = jax.nn.softmax(s, axis=-1).astype(vc.dtype)
        y_ctx = jnp.einsum('bhqk,bkhd->bqhd', p, vc).reshape(B, -1, B_WIDTH) @ wo
    return y_lat, y_ctx


def window_gqa(h_lat, h_ctx, wqkv, wo, sink, ang, with_ctx_out):
    B, S, _ = h_lat.shape
    H, KV, G, d = C_HEADS, C_KV_HEADS, C_GROUP, C_HEAD_DIM
    QB = Q_BLOCK
    C = h_ctx.shape[1]
    scale = d ** -0.5

    def project(h):
        n = h.shape[1]
        q, k, v = jnp.split(h @ wqkv, [H * d, H * d + KV * d], axis=-1)
        return q.reshape(B, n, H, d), k.reshape(B, n, KV, d), v.reshape(B, n, KV, d)

    q, k, v = project(h_lat)
    qc, kc, vc = project(h_ctx)
    q = rope_2d(q, *ang) * scale
    k = rope_2d(k, *ang)
    sink_f = sink.astype(jnp.float32).reshape(KV, G, 1, 1)

    nb = S // QB
    pad = ((0, 0), (QB, QB), (0, 0), (0, 0))
    kb = jnp.pad(k, pad).reshape(B, nb + 2, QB, KV, d)
    vb = jnp.pad(v, pad).reshape(B, nb + 2, QB, KV, d)
    k_band = jnp.concatenate([kb[:, :-2], kb[:, 1:-1], kb[:, 2:]], axis=2).swapaxes(0, 1)
    v_band = jnp.concatenate([vb[:, :-2], vb[:, 1:-1], vb[:, 2:]], axis=2).swapaxes(0, 1)
    qblk = q.reshape(B, nb, QB, KV, G, d).swapaxes(0, 1)
    nband = 3 * QB

    def block(args):
        qb, kk, vv, i = args
        qpos = i * QB + jnp.arange(QB)
        kpos = (i - 1) * QB + jnp.arange(nband)
        valid = (jnp.abs(qpos[:, None] - kpos[None, :]) <= C_WINDOW) & (kpos >= 0)[None, :] & (kpos < S)[None, :]
        s_band = jnp.einsum('bqkgd,bnkd->bkgqn', qb, kk).astype(jnp.float32)
        s_band = jnp.where(valid, s_band, -jnp.inf)
        s_cx = jnp.einsum('bqkgd,bnkd->bkgqn', qb, kc).astype(jnp.float32)
        snk = jnp.broadcast_to(sink_f, (B, KV, G, QB, 1))
        p = jax.nn.softmax(jnp.concatenate([s_band, s_cx, snk], axis=-1), axis=-1).astype(v.dtype)
        return (jnp.einsum('bkgqn,bnkd->bqkgd', p[..., :nband], vv)
                + jnp.einsum('bkgqn,bnkd->bqkgd', p[..., nband:nband + C], vc))

    o = lax.map(block, (qblk, k_band, v_band, jnp.arange(nb)))
    y_lat = o.swapaxes(0, 1).reshape(B, S, H * d) @ wo
    y_ctx = None
    if with_ctx_out:
        s = jnp.einsum('bqkgd,bnkd->bkgqn', qc.reshape(B, C, KV, G, d) * scale, kc).astype(jnp.float32)
        snk = jnp.broadcast_to(sink_f, (B, KV, G, C, 1))
        p = jax.nn.softmax(jnp.concatenate([s, snk], axis=-1), axis=-1).astype(vc.dtype)
        y_ctx = jnp.einsum('bkgqn,bnkd->bqkgd', p[..., :C], vc).reshape(B, C, H * d) @ wo
    return y_lat, y_ctx


def swiglu(h, w13, w2):
    gate, up = jnp.split(h @ w13, 2, axis=-1)
    return (jax.nn.silu(gate) * up) @ w2


def setup_inputs(seed: int = 0) -> dict:
    key = jax.random.key(seed)
    ks = jax.random.split(key, 19)
    D = D_MODEL

    def nrm(k, shape):
        return jax.random.normal(k, shape, jnp.float32)

    def w(k, shape, fan_in):
        return nrm(k, shape) * fan_in ** -0.5

    return {
        "x": nrm(ks[0], (BATCH, SEQ, D)),
        "c": nrm(ks[1], (BATCH, D)),
        "ctx": nrm(ks[2], (BATCH, CTX_LEN, D)),
        "c_ctx": nrm(ks[3], (D,)),
        "ada_w": w(ks[4], (DEPTH, D, 6 * D), D),
        "ada_b": 0.02 * nrm(ks[5], (DEPTH, 6 * D)),
        "norm_g": 1.0 + 0.1 * nrm(ks[6], (DEPTH, 4, D)),
        "ffn_w13": w(ks[7], (DEPTH, D, 2 * FFN_HIDDEN), D),
        "ffn_w2": w(ks[8], (DEPTH, FFN_HIDDEN, D), FFN_HIDDEN),
        "a_wqkv": w(ks[9], (N_A, D, 3 * A_WIDTH), D),
        "a_wo": w(ks[10], (N_A, A_WIDTH, D), A_WIDTH),
        "a_lambda": 0.1 * nrm(ks[11], (N_A, 4, A_HEAD_DIM)),
        "a_subln": 1.0 + 0.1 * nrm(ks[12], (N_A, 2 * A_HEAD_DIM)),
        "b_wqkv": w(ks[13], (N_B, D, 3 * B_WIDTH), D),
        "b_wo": w(ks[14], (N_B, B_WIDTH, D), B_WIDTH),
        "b_rpb": 0.5 * nrm(ks[15], (N_B, B_HEADS, 2 * NA_KH - 1, 2 * NA_KW - 1)),
        "c_wqkv": w(ks[16], (N_C, D, C_QKV), D),
        "c_wo": w(ks[17], (N_C, C_HEADS * C_HEAD_DIM, D), C_HEADS * C_HEAD_DIM),
        "c_sink": nrm(ks[18], (N_C, C_HEADS)),
    }


def reference(x, c, ctx, c_ctx, ada_w, ada_b, norm_g, ffn_w13, ffn_w2,
              a_wqkv, a_wo, a_lambda, a_subln, b_wqkv, b_wo, b_rpb, c_wqkv, c_wo, c_sink):
    S = x.shape[1]
    ang = grid_angles(S, A_HEAD_DIM)
    s_lat = jax.nn.silu(c)
    s_ctx = jax.nn.silu(c_ctx)
    for i in range(DEPTH):
        last = i == DEPTH - 1
        mixer, j = i % N_MIXERS, i // N_MIXERS
        g = norm_g[i]
        mod = (s_lat @ ada_w[i] + ada_b[i])[:, None, :]
        sh1, sc1, gt1, sh2, sc2, gt2 = jnp.split(mod, 6, axis=-1)
        modc = s_ctx @ ada_w[i] + ada_b[i]
        csh1, csc1, cgt1, csh2, csc2, cgt2 = jnp.split(modc, 6, axis=-1)

        h = rmsnorm(x, g[0]) * (1.0 + sc1) + sh1
        hc = rmsnorm(ctx, g[0]) * (1.0 + csc1) + csh1
        if mixer == 0:
            lam_init = 0.8 - 0.6 * math.exp(-0.3 * i)
            y, yc = diff_attention(h, hc, a_wqkv[j], a_wo[j], a_lambda[j], a_subln[j], lam_init, ang, not last)
        elif mixer == 1:
            y, yc = neighbourhood_attention(h, hc, b_wqkv[j], b_wo[j], b_rpb[j], not last)
        else:
            y, yc = window_gqa(h, hc, c_wqkv[j], c_wo[j], c_sink[j], ang, not last)

        x = x + gt1 * rmsnorm(y, g[1])
        h = rmsnorm(x, g[2]) * (1.0 + sc2) + sh2
        x = x + gt2 * rmsnorm(swiglu(h, ffn_w13[i], ffn_w2[i]), g[3])
        if not last:
            ctx = ctx + cgt1 * rmsnorm(yc, g[1])
            hc = rmsnorm(ctx, g[2]) * (1.0 + csc2) + csh2
            ctx = ctx + cgt2 * rmsnorm(swiglu(hc, ffn_w13[i], ffn_w2[i]), g[3])
    return x
```

```cpp
#include <hip/hip_runtime.h>
#include <hip/hip_cooperative_groups.h>
#include <cstdio>
#include <cstdint>
namespace cg = cooperative_groups;

#define LAS __attribute__((address_space(3)))
#define DI __device__ __forceinline__
typedef unsigned short bf16_t;
typedef short bf16x8 __attribute__((ext_vector_type(8)));
typedef short s16x4 __attribute__((ext_vector_type(4)));
typedef float f32x2 __attribute__((ext_vector_type(2)));
typedef float f32x4 __attribute__((ext_vector_type(4)));
typedef float f32x16 __attribute__((ext_vector_type(16)));
typedef unsigned u32x2 __attribute__((ext_vector_type(2)));
typedef unsigned u32x4 __attribute__((ext_vector_type(4)));
typedef __bf16 bf16x2_t __attribute__((ext_vector_type(2)));

constexpr int NCTX = 256, SEQ = 16384, T = NCTX + SEQ, D = 1024, FF = 2816, FF2 = 5632, DEPTH = 4;
constexpr float LOG2E = 1.4426950408889634f;
constexpr float QSCALE = 0.125f * LOG2E;
constexpr float NORM_EPS = 1e-6f;

DI unsigned cvtpk(float lo, float hi) { f32x2 v = {lo, hi}; bf16x2_t b = __builtin_convertvector(v, bf16x2_t); return __builtin_bit_cast(unsigned, b); }
DI float shfl_xor_l(float v, int o, int lane) { return __builtin_bit_cast(float, __builtin_amdgcn_ds_bpermute((lane ^ o) << 2, __builtin_bit_cast(int, v))); }
DI float xhalf_max(float v) { float a = v, b = v; asm volatile("s_nop 1\n\tv_permlane32_swap_b32 %0, %1" : "+v"(a), "+v"(b)); return fmaxf(a, b); }
DI float wave_sum(float v, int lane) {
#pragma unroll
    for (int o = 1; o < 64; o <<= 1) v += shfl_xor_l(v, o, lane);
    return v;
}
#define LDS_WAIT() asm volatile("s_waitcnt lgkmcnt(0)" ::: "memory")

namespace pg8 {
#define PG8_LAS __attribute__((address_space(3)))
constexpr int BM = 256, BK = 64, HALF = 128, HTB = HALF * BK * 2  , STAGE_BYTES = 8 * HTB, NXCD = 8, WGM = 8;

__host__ __device__ __forceinline__ int lds_byte(int r, int c) { const int st = (r >> 4) * 2 + (c >> 5), rr = r & 15, cc = c & 31, ob = rr * 64 + cc * 2; return st * 1024 + (ob ^ (((ob >> 9) & 1) << 5)); }
__host__ __device__ __forceinline__ void stage_rc(int b, int& R, int& C) { const int st = b / 1024, sb = b % 1024, swz = sb ^ (((sb >> 9) & 1) << 5); R = (st >> 1) * 16 + swz / 64; C = (st & 1) * 32 + (swz % 64) / 2; }
__host__ __device__ __forceinline__ int perm32(int rho) { const int n = rho >> 4, i = rho & 15; return 8 * (i >> 2) + 4 * n + (i & 3); }

struct Unit { int pm, pn, g; const char* a; const char* b; };
template <class Epi, class Sched, bool ALIGN_EPI = false, bool SP2 = false>
__device__ __forceinline__ void gemm_phase(PG8_LAS unsigned char* lds, const int K, const int ldk, const Sched& S, const Epi& E, const int tid) {
    const int wid = __builtin_amdgcn_readfirstlane(tid >> 6), lane = tid & 63, wr = wid >> 2, wc = wid & 3, fr = lane & 15, fq = lane >> 4;
    const int nt = K / BK;
    unsigned voffA[2], voffB[2];
#pragma unroll
    for (int i = 0; i < 2; ++i) { int R, C; stage_rc(tid * 16 + i * 8192, R, C); const int Rb = Epi::PERM ? ((R & ~31) + perm32(R & 31)) : R;
        voffA[i] = (unsigned)(R * ldk + C) * 2u; voffB[i] = (unsigned)(Rb * ldk + C) * 2u; }
    const size_t kstep = (size_t)(BK * 2);
    const size_t hstep = (size_t)HALF * ldk * 2;
    const unsigned ldsw = (unsigned)wid * 1024u;
    const int aoff = lds_byte(wr * 64 + fr, fq * 8), boff = lds_byte(wc * 32 + fr, fq * 8);
#define PG8_SA(b, h) (((b) * 2 + (h)) * HTB)
#define PG8_SB(b, h) ((4 + (b) * 2 + (h)) * HTB)
#define PG8_STAGE(bufoff, gbase, voff) do { _Pragma("unroll") for (int _i = 0; _i < 2; ++_i) \
        __builtin_amdgcn_global_load_lds((const unsigned*)((const char*)(gbase) + (voff)[_i]), (PG8_LAS unsigned*)(lds + (bufoff) + ldsw + _i * 8192), 16, 0, 0); } while (0)
#define PG8_LDA(dst, b, h) do { _Pragma("unroll") for (int m = 0; m < 4; ++m) _Pragma("unroll") for (int k = 0; k < 2; ++k) dst[m][k] = *(const PG8_LAS bf16x8*)(lds + PG8_SA(b, h) + aoff + m * 2048 + k * 1024); } while (0)
#define PG8_LDB(dst, b, h) do { _Pragma("unroll") for (int n = 0; n < 2; ++n) _Pragma("unroll") for (int k = 0; k < 2; ++k) dst[n][k] = *(const PG8_LAS bf16x8*)(lds + PG8_SB(b, h) + boff + n * 2048 + k * 1024); } while (0)
#define PG8_MMA(ai, bj, At, Bt) do { __builtin_amdgcn_s_setprio(1); _Pragma("unroll") for (int m = 0; m < 4; ++m) _Pragma("unroll") for (int n = 0; n < 2; ++n) _Pragma("unroll") for (int k = 0; k < 2; ++k) \
        acc[ai][bj][m][n] = __builtin_amdgcn_mfma_f32_16x16x32_bf16(Bt[n][k], At[m][k], acc[ai][bj][m][n], 0, 0, 0); __builtin_amdgcn_s_setprio(0); } while (0)
#define PG8_WAIT_V(n) asm volatile("s_waitcnt vmcnt(" #n ")" ::: "memory")
#define PG8_WAIT_L(n) asm volatile("s_waitcnt lgkmcnt(" #n ")" ::: "memory")
#define PG8_BAR __builtin_amdgcn_s_barrier()
#define PG8_SCHED __builtin_amdgcn_sched_barrier(0)
    Unit cur, nxt; int ui = 0;
    if (!S.next(0, cur)) return;
    f32x4 acc[2][2][4][2];
#pragma unroll
    for (int a = 0; a < 2; ++a)
#pragma unroll
        for (int b = 0; b < 2; ++b)
#pragma unroll
            for (int m = 0; m < 4; ++m)
#pragma unroll
                for (int n = 0; n < 2; ++n) acc[a][b][m][n] = (f32x4){0.f, 0.f, 0.f, 0.f};
    bf16x8 At[4][2], B0[2][2], B1[2][2];
    const char* cA = cur.a; const char* cB = cur.b;
    S.a_ready(cur);
    if constexpr (SP2) {
        PG8_STAGE(PG8_SB(0, 0), cB, voffB); PG8_STAGE(PG8_SB(0, 1), cB + hstep, voffB); PG8_STAGE(PG8_SA(0, 0), cA, voffA); PG8_STAGE(PG8_SA(0, 1), cA + hstep, voffA);
        if (wr == 1) PG8_BAR;
        PG8_WAIT_V(2); PG8_BAR;
        PG8_STAGE(PG8_SB(1, 0), cB + kstep, voffB); PG8_STAGE(PG8_SA(1, 0), cA + kstep, voffA); PG8_STAGE(PG8_SB(1, 1), cB + hstep + kstep, voffB);
        PG8_WAIT_V(6); PG8_BAR;
    } else {
        PG8_STAGE(PG8_SB(0, 0), cB, voffB); PG8_STAGE(PG8_SA(0, 0), cA, voffA); PG8_STAGE(PG8_SB(0, 1), cB + hstep, voffB); PG8_STAGE(PG8_SA(0, 1), cA + hstep, voffA);
        if (wr == 1) PG8_BAR;
        PG8_WAIT_V(4); PG8_BAR;
        PG8_STAGE(PG8_SB(1, 0), cB + kstep, voffB); PG8_STAGE(PG8_SA(1, 0), cA + kstep, voffA); PG8_STAGE(PG8_SB(1, 1), cB + hstep + kstep, voffB);
        PG8_WAIT_V(6); PG8_BAR;
    }
    for (;;) {
        const bool has_next = S.next(ui + 1, nxt);
        const char* nA = has_next ? nxt.a : cA; const char* nB = has_next ? nxt.b : cB;
        for (int t = 0; t < nt; t += 2) {
            const bool last = (t == nt - 2);
            const char* a1 = cA + (size_t)(t + 1) * kstep;
            const char* a2 = last ? nA : cA + (size_t)(t + 2) * kstep; const char* b2 = last ? nB : cB + (size_t)(t + 2) * kstep;
            const char* a3 = a2 + kstep; const char* b3 = b2 + kstep;
            if (last && has_next) S.a_ready(nxt);
            if constexpr (SP2) {
            PG8_LDB(B0, 0, 0); PG8_LDB(B1, 0, 1); PG8_SCHED; PG8_LDA(At, 0, 0); PG8_STAGE(PG8_SA(1, 1), a1 + hstep, voffA);
            PG8_WAIT_V(8); PG8_WAIT_L(0); PG8_BAR; PG8_MMA(0, 0, At, B0); PG8_MMA(0, 1, At, B1); PG8_BAR; PG8_SCHED;
            PG8_LDA(At, 0, 1); PG8_STAGE(PG8_SB(0, 0), b2, voffB); PG8_STAGE(PG8_SB(0, 1), b2 + hstep, voffB); PG8_STAGE(PG8_SA(0, 0), a2, voffA);
            PG8_WAIT_V(8); PG8_WAIT_L(0); PG8_BAR; PG8_MMA(1, 0, At, B0); PG8_MMA(1, 1, At, B1); PG8_BAR; PG8_SCHED;
            PG8_LDB(B0, 1, 0); PG8_LDB(B1, 1, 1); PG8_SCHED; PG8_LDA(At, 1, 0); PG8_STAGE(PG8_SA(0, 1), a2 + hstep, voffA);
            PG8_WAIT_V(8); PG8_WAIT_L(0); PG8_BAR; PG8_MMA(0, 0, At, B0); PG8_MMA(0, 1, At, B1); PG8_BAR; PG8_SCHED;
            PG8_LDA(At, 1, 1); PG8_STAGE(PG8_SB(1, 0), b3, voffB); PG8_STAGE(PG8_SB(1, 1), b3 + hstep, voffB); PG8_STAGE(PG8_SA(1, 0), a3, voffA);
            PG8_WAIT_V(8); PG8_WAIT_L(0); PG8_BAR; PG8_MMA(1, 0, At, B0); PG8_MMA(1, 1, At, B1); PG8_BAR; PG8_SCHED;
            } else {
            PG8_LDB(B0, 0, 0); PG8_SCHED; PG8_LDA(At, 0, 0); PG8_STAGE(PG8_SA(1, 1), a1 + hstep, voffA);
            PG8_WAIT_L(8); PG8_BAR; PG8_WAIT_L(0); PG8_MMA(0, 0, At, B0); PG8_BAR; PG8_SCHED;
            PG8_LDB(B1, 0, 1); PG8_STAGE(PG8_SB(0, 0), b2, voffB);
            PG8_BAR; PG8_WAIT_L(0); PG8_MMA(0, 1, At, B1); PG8_BAR;
            PG8_LDA(At, 0, 1); PG8_STAGE(PG8_SA(0, 0), a2, voffA);
            PG8_BAR; PG8_WAIT_L(0); PG8_MMA(1, 0, At, B0); PG8_BAR; PG8_SCHED;
            PG8_STAGE(PG8_SB(0, 1), b2 + hstep, voffB);
            PG8_WAIT_V(6); PG8_BAR; PG8_MMA(1, 1, At, B1); PG8_BAR;
            PG8_LDB(B0, 1, 0); PG8_SCHED; PG8_LDA(At, 1, 0); PG8_STAGE(PG8_SA(0, 1), a2 + hstep, voffA);
            PG8_WAIT_L(8); PG8_BAR; PG8_WAIT_L(0); PG8_MMA(0, 0, At, B0); PG8_BAR; PG8_SCHED;
            PG8_LDB(B1, 1, 1); PG8_STAGE(PG8_SB(1, 0), b3, voffB);
            PG8_BAR; PG8_WAIT_L(0); PG8_MMA(0, 1, At, B1); PG8_BAR;
            PG8_LDA(At, 1, 1); PG8_STAGE(PG8_SA(1, 0), a3, voffA);
            PG8_BAR; PG8_WAIT_L(0); PG8_MMA(1, 0, At, B0); PG8_BAR; PG8_SCHED;
            PG8_STAGE(PG8_SB(1, 1), b3 + hstep, voffB);
            PG8_WAIT_V(6); PG8_BAR; PG8_MMA(1, 1, At, B1); PG8_BAR;
            }
        }
        if constexpr (ALIGN_EPI) { if (wr == 0) PG8_BAR; }
        if constexpr (!Epi::AFTER_DRAIN) { E(acc, cur, wr, wc, fr, fq); S.done(cur); }
        if (!has_next) break;
#pragma unroll
        for (int a = 0; a < 2; ++a)
#pragma unroll
            for (int b = 0; b < 2; ++b)
#pragma unroll
                for (int m = 0; m < 4; ++m)
#pragma unroll
                    for (int n = 0; n < 2; ++n) acc[a][b][m][n] = (f32x4){0.f, 0.f, 0.f, 0.f};
        cur = nxt; cA = nA; cB = nB; ++ui;
        if constexpr (ALIGN_EPI) { if (wr == 1) PG8_BAR; }
    }
    PG8_WAIT_V(0);
    if constexpr (!ALIGN_EPI) { if (wr == 0) PG8_BAR; }
    PG8_BAR;
    if constexpr (Epi::AFTER_DRAIN) { E.fused(acc, cur, wr, wc, fr, fq, lds, wid, lane); S.done(cur); }
#undef PG8_SA
#undef PG8_SB
#undef PG8_STAGE
#undef PG8_LDA
#undef PG8_LDB
#undef PG8_MMA
#undef PG8_WAIT_V
#undef PG8_WAIT_L
#undef PG8_BAR
#undef PG8_SCHED
}
}

struct MSched {
    const bf16_t *A0, *B0, *A1, *B1; int nM0, nN0, nM1, nN1, n0, ntot, G, c, K;
    DI void init(const bf16_t* a0, const bf16_t* b0, int m0, int nn0, const bf16_t* a1, const bf16_t* b1, int m1, int nn1, int K_, int G_, int c_) {
        A0 = a0; B0 = b0; nM0 = m0; nN0 = nn0; A1 = a1; B1 = b1; nM1 = m1; nN1 = nn1; n0 = m0 * nn0; ntot = n0 + m1 * nn1; K = K_; G = G_; c = c_;
    }
    DI bool next(int i, pg8::Unit& u) const {
        const long L = (long)i * G + c; if (L >= ntot) return false;
        int wgid = (int)L; { const int q = ntot / 8, r = ntot % 8, xcd = wgid % 8, off = wgid / 8; wgid = (xcd < r ? xcd * (q + 1) : r * (q + 1) + (xcd - r) * q) + off; }
        const int gi = wgid >= n0 ? 1 : 0; const int w = gi ? wgid - n0 : wgid;
        const int nM = gi ? nM1 : nM0, nN = gi ? nN1 : nN0;
        const int nig = 8 * nN, gid = w / nig, fm = gid * 8, gsz = (nM - fm) < 8 ? (nM - fm) : 8;
        u.pm = fm + ((w % nig) % gsz); u.pn = (w % nig) / gsz; u.g = gi;
        u.a = (const char*)(gi ? A1 : A0) + (size_t)u.pm * 256 * K * 2; u.b = (const char*)(gi ? B1 : B0) + (size_t)u.pn * 256 * K * 2;
        return true;
    }
    DI void a_ready(const pg8::Unit&) const {}
    DI void done(const pg8::Unit&) const {}
};

struct KSched {
    const bf16_t *A, *B; int ns, ldk, G, c;
    DI bool next(int i, pg8::Unit& u) const {
        const int L = i * G + c; if (L >= 4 * ns) return false;
        u.pm = 0; u.pn = L & 3; u.g = L >> 2;
        u.a = (const char*)A + (size_t)u.g * 256 * 2; u.b = (const char*)B + ((size_t)u.pn * 256 * ldk + (size_t)u.g * 256) * 2;
        return true;
    }
    DI void a_ready(const pg8::Unit&) const {}
    DI void done(const pg8::Unit&) const {}
};

struct EpiQKV {
    static constexpr bool PERM = false, AFTER_DRAIN = false;
    bf16_t* Q; bf16_t* Kb; bf16_t* Vt; int kw; int rope;
    DI void operator()(const f32x4 (&acc)[2][2][4][2], const pg8::Unit& u, int wr, int wc, int fr, int fq) const {
        asm volatile("" : "+v"(fr), "+v"(fq));
        if (u.g == 1) {
#pragma unroll
            for (int ai = 0; ai < 2; ++ai)
#pragma unroll
                for (int m = 0; m < 4; ++m) {
                    const int row = u.pm * 256 + ai * 128 + wr * 64 + m * 16 + fr;
                    bf16_t* rp = Vt + (size_t)row * T + u.pn * 256 + wc * 32 + 8 * (fq & 1) + 4 * (fq >> 1);
#pragma unroll
                    for (int bj = 0; bj < 2; ++bj)
#pragma unroll
                        for (int n = 0; n < 2; ++n) { const f32x4 v = acc[ai][bj][m][n]; u32x2 w; w.x = cvtpk(v[0], v[1]); w.y = cvtpk(v[2], v[3]); *(u32x2*)(rp + bj * 128 + n * 16) = w; }
                }
            return;
        }
        const int ct = u.pn * 256; const bool isq = ct < 1024;
        bf16_t* base = isq ? Q : Kb; const int ld = isq ? 1024 : kw; const int c0 = (isq ? ct : ct - 1024) + wc * 32 + 4 * fq;
        const float qs = isq ? QSCALE : 1.f;
        float frev[4];
#pragma unroll
        for (int e = 0; e < 4; ++e) frev[e] = exp2f(-(float)(4 * fq + e) * 0.83048202372184f) * 0.15915494309189535f;
#pragma unroll
        for (int ai = 0; ai < 2; ++ai)
#pragma unroll
            for (int m = 0; m < 4; ++m) {
                const int row = u.pm * 256 + ai * 128 + wr * 64 + m * 16 + fr;
                const bool lat = row >= NCTX; const int p = row - NCTX; const int pos = (wc & 1) ? (p & 63) : (p >> 6);
                float cs[4], sn[4];
#pragma unroll
                for (int e = 0; e < 4; ++e) { const float a = (float)pos * frev[e]; const bool rr = rope && lat; cs[e] = rr ? __builtin_amdgcn_cosf(a) : 1.f; sn[e] = rr ? __builtin_amdgcn_sinf(a) : 0.f; }
                bf16_t* rp = base + (size_t)row * ld + c0;
#pragma unroll
                for (int bj = 0; bj < 2; ++bj) {
                    const f32x4 x1 = acc[ai][bj][m][0], x2 = acc[ai][bj][m][1]; float o1[4], o2[4];
#pragma unroll
                    for (int e = 0; e < 4; ++e) { o1[e] = (x1[e] * cs[e] - x2[e] * sn[e]) * qs; o2[e] = (x2[e] * cs[e] + x1[e] * sn[e]) * qs; }
                    u32x2 w1, w2; w1.x = cvtpk(o1[0], o1[1]); w1.y = cvtpk(o1[2], o1[3]); w2.x = cvtpk(o2[0], o2[1]); w2.y = cvtpk(o2[2], o2[3]);
                    *(u32x2*)(rp + bj * 128) = w1; *(u32x2*)(rp + bj * 128 + 16) = w2;
                }
            }
    }
};
struct EpiY {
    static constexpr bool PERM = true, AFTER_DRAIN = false;
    bf16_t* Y;
    DI void operator()(const f32x4 (&acc)[2][2][4][2], const pg8::Unit& u, int wr, int wc, int fr, int fq) const {
        asm volatile("" : "+v"(fr), "+v"(fq));
#pragma unroll
        for (int ai = 0; ai < 2; ++ai)
#pragma unroll
            for (int m = 0; m < 4; ++m) {
                const int row = u.pm * 256 + ai * 128 + wr * 64 + m * 16 + fr;
                bf16_t* rp = Y + (size_t)row * D + u.pn * 256 + wc * 32 + 8 * fq;
#pragma unroll
                for (int bj = 0; bj < 2; ++bj) { const f32x4 v0 = acc[ai][bj][m][0], v1 = acc[ai][bj][m][1];
                    u32x4 w4; w4.x = cvtpk(v0[0], v0[1]); w4.y = cvtpk(v0[2], v0[3]); w4.z = cvtpk(v1[0], v1[1]); w4.w = cvtpk(v1[2], v1[3]);
                    *(u32x4*)(rp + bj * 128) = w4; }
            }
    }
};
struct EpiYP {
    static constexpr bool PERM = true, AFTER_DRAIN = false;
    float* YP;
    DI void operator()(const f32x4 (&acc)[2][2][4][2], const pg8::Unit& u, int wr, int wc, int fr, int fq) const {
        asm volatile("" : "+v"(fr), "+v"(fq));
#pragma unroll
        for (int ai = 0; ai < 2; ++ai)
#pragma unroll
            for (int m = 0; m < 4; ++m) {
                const int row = ai * 128 + wr * 64 + m * 16 + fr;
                float* rp = YP + ((size_t)u.g * 256 + row) * D + u.pn * 256 + wc * 32 + 8 * fq;
#pragma unroll
                for (int bj = 0; bj < 2; ++bj)
#pragma unroll
                    for (int n = 0; n < 2; ++n) *(f32x4*)(rp + bj * 128 + 4 * n) = acc[ai][bj][m][n];
            }
    }
};
DI float silu_mul(float g, float u) { return g * u * __builtin_amdgcn_rcpf(1.f + __builtin_amdgcn_exp2f(-g * LOG2E)); }
struct EpiSwi {
    static constexpr bool PERM = true, AFTER_DRAIN = false;
    bf16_t* ACT;
    DI void operator()(const f32x4 (&acc)[2][2][4][2], const pg8::Unit& u, int wr, int wc, int fr, int fq) const {
        asm volatile("" : "+v"(fr), "+v"(fq));
#pragma unroll
        for (int ai = 0; ai < 2; ++ai)
#pragma unroll
            for (int m = 0; m < 4; ++m) {
                const int row = u.pm * 256 + ai * 128 + wr * 64 + m * 16 + fr;
                bf16_t* rp = ACT + (size_t)row * FF + u.pn * 128 + wc * 32 + 8 * fq;
                const f32x4 g0 = acc[ai][0][m][0], g1 = acc[ai][0][m][1], u0 = acc[ai][1][m][0], u1 = acc[ai][1][m][1];
                u32x4 w;
                w.x = cvtpk(silu_mul(g0[0], u0[0]), silu_mul(g0[1], u0[1])); w.y = cvtpk(silu_mul(g0[2], u0[2]), silu_mul(g0[3], u0[3]));
                w.z = cvtpk(silu_mul(g1[0], u1[0]), silu_mul(g1[1], u1[1])); w.w = cvtpk(silu_mul(g1[2], u1[2]), silu_mul(g1[3], u1[3]));
                *(u32x4*)rp = w;
            }
    }
};

constexpr size_t MiB = 1u << 20;
constexpr size_t WS_MOD = 0;
constexpr size_t WS_BAR = 512 * 1024;
constexpr size_t WS_WT = 1 * MiB;
constexpr size_t LWT = (size_t)12544 * 1024;
constexpr size_t WT_QKV = 0, WT_O = (size_t)3072 * 1024, WT_13 = (size_t)4096 * 1024, WT_2 = (size_t)9728 * 1024;
constexpr size_t WS_X = 99 * MiB;
constexpr size_t WS_H = 164 * MiB;
constexpr size_t WS_Q = 197 * MiB;
constexpr size_t WS_K = 230 * MiB;
constexpr size_t WS_VT = 263 * MiB;
constexpr size_t WS_ACT = WS_Q;
constexpr size_t WS_Y = 296 * MiB;
constexpr size_t WS_YP = 362 * MiB;
constexpr size_t WS_END = 374 * MiB;
static_assert(WS_WT + 4 * LWT * 2 <= WS_X && WS_X + (size_t)T * D * 4 <= WS_H && WS_H + (size_t)T * D * 2 <= WS_Q && WS_Q + (size_t)T * D * 2 <= WS_K && WS_K + (size_t)T * D * 2 <= WS_VT &&
              WS_VT + (size_t)T * D * 2 <= WS_Y && WS_ACT + (size_t)T * FF * 2 <= WS_Y && WS_Y + (size_t)T * D * 4 <= WS_YP && WS_YP + (size_t)11 * 256 * D * 4 <= WS_END, "workspace map");

struct Args { const float* in[19]; float* out; unsigned char* ws; int ph_lo, ph_hi; };

DI void transpose_item(const float* W, int K, int N, bf16_t* WT, int k0, int n0, int out_row0, LAS float* scr, int lane) {
#pragma unroll 8
    for (int i = 0; i < 32; ++i) { const int kk = 2 * i + (lane >> 5); scr[kk * 33 + (lane & 31)] = W[(size_t)(k0 + kk) * N + n0 + (lane & 31)]; }
    LDS_WAIT();
    const int c = lane & 7;
#pragma unroll
    for (int j = 0; j < 4; ++j) { const int n = (lane >> 3) + 8 * j; const LAS float* s = scr + (8 * c) * 33 + n;
        u32x4 o; o.x = cvtpk(s[0 * 33], s[1 * 33]); o.y = cvtpk(s[2 * 33], s[3 * 33]); o.z = cvtpk(s[4 * 33], s[5 * 33]); o.w = cvtpk(s[6 * 33], s[7 * 33]);
        *(u32x4*)(WT + (size_t)(out_row0 + n) * K + k0 + 8 * c) = o; }
    LDS_WAIT();
}
DI float silu_f(float x) { return x / (1.f + expf(-x)); }

DI void phase_p0(const Args& a, LAS unsigned char* lds, const int tid, const int bid) {
    const int lane = tid & 63, wave = __builtin_amdgcn_readfirstlane(tid >> 6), G = gridDim.x;
    float* mod = (float*)(a.ws + WS_MOD);
    {
        LAS float* sl = (LAS float*)lds; LAS float* sc = sl + 1024; LAS float* red = sc + 1024;
        const float* cin = a.in[1]; const float* cctx = a.in[3]; const float* ada_w = a.in[4]; const float* ada_b = a.in[5];
        for (int it = bid; it < DEPTH * 24; it += G) {
            const int li = it / 24, c0 = (it % 24) * 256;
            for (int k = tid; k < 1024; k += 512) { sl[k] = silu_f(cin[k]); sc[k] = silu_f(cctx[k]); }
            __syncthreads();
            f32x4 al = {0.f, 0.f, 0.f, 0.f}, ac = {0.f, 0.f, 0.f, 0.f};
            const float* wp = ada_w + ((size_t)li * 1024 + wave * 128) * 6144 + c0 + 4 * lane;
#pragma unroll 8
            for (int k = 0; k < 128; ++k) { const f32x4 w4 = *(const f32x4*)(wp + (size_t)k * 6144); const float s1 = sl[wave * 128 + k], s2 = sc[wave * 128 + k]; al += w4 * s1; ac += w4 * s2; }
#pragma unroll
            for (int e = 0; e < 4; ++e) { red[(0 * 8 + wave) * 256 + 4 * lane + e] = al[e]; red[(1 * 8 + wave) * 256 + 4 * lane + e] = ac[e]; }
            __syncthreads();
            { const int src = tid >> 8, col = tid & 255; float s = ada_b[li * 6144 + c0 + col];
#pragma unroll
              for (int w = 0; w < 8; ++w) s += red[(src * 8 + w) * 256 + col];
              mod[(size_t)(li * 2 + src) * 6144 + c0 + col] = s; }
            __syncthreads();
        }
    }
    {
        LAS float* scr = (LAS float*)(lds + 32768 + wave * 8704);
        const int gw = bid * 8 + wave, NGW = G * 8;
        for (int li = 0; li < DEPTH; ++li) {
            const int mixer = li % 3, j = li / 3;
            const float* wqkv = mixer == 0 ? a.in[9] + (size_t)j * 1024 * 3072 : (mixer == 1 ? a.in[13] : a.in[16]);
            const float* wo = mixer == 0 ? a.in[10] + (size_t)j * 1024 * 1024 : (mixer == 1 ? a.in[14] : a.in[17]);
            const float* w13 = a.in[7] + (size_t)li * 1024 * FF2; const float* w2 = a.in[8] + (size_t)li * FF * 1024;
            const int nqkv = mixer == 2 ? 1536 : 3072;
            bf16_t* wt = (bf16_t*)(a.ws + WS_WT) + (size_t)li * LWT;
            const int I_qkv = 16 * (nqkv / 32), I_o = 16 * 32, I_13 = 16 * (FF2 / 32), I_2 = (FF / 64) * 32;
            const int NIT = I_qkv + I_o + I_13 + I_2;
            for (int it = gw; it < NIT; it += NGW) {
                int r = it;
                if (r < I_qkv) { const int nb = nqkv / 32; const int kb = r / nb, n0 = (r % nb) * 32; transpose_item(wqkv, 1024, nqkv, wt + WT_QKV, kb * 64, n0, n0, scr, lane); continue; } r -= I_qkv;
                if (r < I_o) { const int kb = r / 32, n0 = (r % 32) * 32; transpose_item(wo, 1024, 1024, wt + WT_O, kb * 64, n0, n0, scr, lane); continue; } r -= I_o;
                if (r < I_13) { const int nb = FF2 / 32; const int kb = r / nb, n0 = (r % nb) * 32;
                    const int n2 = n0 < FF ? n0 : n0 - FF; const int orow = 256 * (n2 / 128) + (n0 < FF ? 0 : 128) + (n2 % 128);
                    transpose_item(w13, 1024, FF2, wt + WT_13, kb * 64, n0, orow, scr, lane); continue; } r -= I_13;
                { const int kb = r / 32, n0 = (r % 32) * 32; transpose_item(w2, FF, 1024, wt + WT_2, kb * 64, n0, n0, scr, lane); }
            }
        }
    }
}

template <int MODE>
DI void row_body(const Args& a, int li, int row, bool last, f32x4 (&x)[4], const f32x4 (&y)[4], const f32x4 (&vg)[4], const f32x4 (&vt)[4], const f32x4 (&vgn)[4], const f32x4 (&vsh)[4], const f32x4 (&vsc)[4], int lane) {
    float* X = (float*)(a.ws + WS_X); bf16_t* H = (bf16_t*)(a.ws + WS_H);
    if (MODE != 0) {
        float ss = 0.f;
#pragma unroll
        for (int j = 0; j < 4; ++j) ss += (y[j][0] * y[j][0] + y[j][1] * y[j][1]) + (y[j][2] * y[j][2] + y[j][3] * y[j][3]);
        const float rs = 1.f / sqrtf(wave_sum(ss, lane) * (1.f / D) + NORM_EPS);
#pragma unroll
        for (int j = 0; j < 4; ++j) x[j] += vt[j] * (y[j] * rs * vg[j]);
    }
    if (last) {
#pragma unroll
        for (int j = 0; j < 4; ++j) *(f32x4*)(a.out + (size_t)(row - NCTX) * D + 4 * lane + 256 * j) = x[j];
        return;
    }
#pragma unroll
    for (int j = 0; j < 4; ++j) *(f32x4*)(X + (size_t)row * D + 4 * lane + 256 * j) = x[j];
    float s2 = 0.f;
#pragma unroll
    for (int j = 0; j < 4; ++j) s2 += (x[j][0] * x[j][0] + x[j][1] * x[j][1]) + (x[j][2] * x[j][2] + x[j][3] * x[j][3]);
    const float r2 = 1.f / sqrtf(wave_sum(s2, lane) * (1.f / D) + NORM_EPS);
#pragma unroll
    for (int j = 0; j < 4; ++j) {
        const f32x4 h = (x[j] * r2 * vgn[j]) * (vsc[j] + 1.f) + vsh[j];
        u32x2 w; w.x = cvtpk(h[0], h[1]); w.y = cvtpk(h[2], h[3]);
        *(u32x2*)(H + (size_t)row * D + 4 * lane + 256 * j) = w;
    }
}
template <int MODE>
DI void row_vectors(const Args& a, int li, int cls, bool last, f32x4 (&vg)[4], f32x4 (&vt)[4], f32x4 (&vgn)[4], f32x4 (&vsh)[4], f32x4 (&vsc)[4], int lane) {
    const float* mod = (const float*)(a.ws + WS_MOD); const float* norm_g = a.in[6];
    const int ln = MODE == 2 ? li + 1 : li;
    const float* mrow = mod + (size_t)(li * 2 + cls) * 6144;
    const float* gy = norm_g + (size_t)(li * 4 + (MODE == 1 ? 1 : 3)) * D; const float* gt = mrow + (MODE == 1 ? 2 : 5) * D;
#pragma unroll
    for (int j = 0; j < 4; ++j) { if (MODE != 0) { vg[j] = *(const f32x4*)(gy + 4 * lane + 256 * j); vt[j] = *(const f32x4*)(gt + 4 * lane + 256 * j); } else { vg[j] = (f32x4){0.f, 0.f, 0.f, 0.f}; vt[j] = vg[j]; } }
    if (!last) {
        const float* mn = mod + (size_t)(ln * 2 + cls) * 6144;
        const float* gn = norm_g + (size_t)(ln * 4 + (MODE == 1 ? 2 : 0)) * D; const float* shp = mn + (MODE == 1 ? 3 : 0) * D; const float* scp = mn + (MODE == 1 ? 4 : 1) * D;
#pragma unroll
        for (int j = 0; j < 4; ++j) { vgn[j] = *(const f32x4*)(gn + 4 * lane + 256 * j); vsh[j] = *(const f32x4*)(shp + 4 * lane + 256 * j); vsc[j] = *(const f32x4*)(scp + 4 * lane + 256 * j); }
    } else {
#pragma unroll
        for (int j = 0; j < 4; ++j) { vgn[j] = (f32x4){0.f, 0.f, 0.f, 0.f}; vsh[j] = vgn[j]; vsc[j] = vgn[j]; }
    }
}
DI void unpack_bf16x4(const u32x2 yb, f32x4& y) { y[0] = __builtin_bit_cast(float, yb.x << 16); y[1] = __builtin_bit_cast(float, yb.x & 0xffff0000u); y[2] = __builtin_bit_cast(float, yb.y << 16); y[3] = __builtin_bit_cast(float, yb.y & 0xffff0000u); }

template <int MODE>
DI void rowpass(const Args& a, int li, const int tid, const int bid) {
    const int lane = tid & 63, wave = __builtin_amdgcn_readfirstlane(tid >> 6);
    const int gw = bid * 8 + wave, NGW = gridDim.x * 8;
    const float* X = (const float*)(a.ws + WS_X); const bf16_t* Y = (const bf16_t*)(a.ws + WS_Y);
    const bool last = (MODE == 2 && li == DEPTH - 1);
    f32x4 vg[4], vt[4], vgn[4], vsh[4], vsc[4];
    int row = gw;
    if (row < NCTX) {
        if (!last) {
            row_vectors<MODE>(a, li, 1, last, vg, vt, vgn, vsh, vsc, lane);
            f32x4 x[4], y[4];
#pragma unroll
            for (int j = 0; j < 4; ++j) {
                if (MODE == 0) { x[j] = *(const f32x4*)(a.in[2] + (size_t)row * D + 4 * lane + 256 * j); y[j] = x[j]; }
                else { x[j] = *(const f32x4*)(X + (size_t)row * D + 4 * lane + 256 * j);
                    const float* yp = (const float*)(a.ws + WS_YP) + (size_t)row * D + 4 * lane + 256 * j; y[j] = *(const f32x4*)yp;
                    for (int sl = 1; sl < (MODE == 1 ? 4 : 11); ++sl) y[j] += *(const f32x4*)(yp + (size_t)sl * 256 * D); }
            }
            row_body<MODE>(a, li, row, last, x, y, vg, vt, vgn, vsh, vsc, lane);
        }
        row += NGW;
    }
    if (row >= T) return;
    row_vectors<MODE>(a, li, 0, last, vg, vt, vgn, vsh, vsc, lane);
    f32x4 xc[4]; u32x2 yc[4];
#pragma unroll
    for (int j = 0; j < 4; ++j) {
        if (MODE == 0) { xc[j] = *(const f32x4*)(a.in[0] + (size_t)(row - NCTX) * D + 4 * lane + 256 * j); yc[j] = (u32x2){0u, 0u}; }
        else { xc[j] = *(const f32x4*)(X + (size_t)row * D + 4 * lane + 256 * j); yc[j] = *(const u32x2*)(Y + (size_t)row * D + 4 * lane + 256 * j); }
    }
    for (; row < T; row += NGW) {
        const int nrow = row + NGW; const bool more = nrow < T;
        f32x4 xn[4]; u32x2 yn[4];
#pragma unroll
        for (int j = 0; j < 4; ++j) { xn[j] = xc[j]; yn[j] = yc[j]; }
        if (more) {
#pragma unroll
            for (int j = 0; j < 4; ++j) {
                if (MODE == 0) xn[j] = *(const f32x4*)(a.in[0] + (size_t)(nrow - NCTX) * D + 4 * lane + 256 * j);
                else { xn[j] = *(const f32x4*)(X + (size_t)nrow * D + 4 * lane + 256 * j); yn[j] = *(const u32x2*)(Y + (size_t)nrow * D + 4 * lane + 256 * j); }
            }
        }
        f32x4 x[4], y[4];
#pragma unroll
        for (int j = 0; j < 4; ++j) { x[j] = xc[j]; unpack_bf16x4(yc[j], y[j]); }
        row_body<MODE>(a, li, row, last, x, y, vg, vt, vgn, vsh, vsc, lane);
#pragma unroll
        for (int j = 0; j < 4; ++j) { xc[j] = xn[j]; yc[j] = yn[j]; }
    }
}

template <int MODE> struct AttnCfg {
    static constexpr int NC = MODE == 0 ? 2 : 1, DV = MODE == 0 ? 128 : 64, NDT = DV / 32, PPR = NC * 8, RB = NC * 128;
    static constexpr int KT_BYTES = 64 * RB, VT_BYTES = DV * 128, STAGE = KT_BYTES + VT_BYTES, NSTG = 3, NIK = KT_BYTES / 8192, NIV = VT_BYTES / 8192, NL = NIK + NIV;
    static constexpr int NH = MODE == 0 ? 8 : 16, KW = MODE == 2 ? 256 : 1024;
};
#define MFMA32(a, b, c) __builtin_amdgcn_mfma_f32_32x32x16_bf16((a), (b), (c), 0, 0, 0)
DI float max3f(float a, float b, float c) { float r; asm("v_max3_f32 %0, %1, %2, %3" : "=v"(r) : "v"(a), "v"(b), "v"(c)); return r; }
DI int crow(int i, int hh) { return (i & 3) + 8 * (i >> 2) + 4 * hh; }
#define ATT_WAIT_V(n) asm volatile("s_waitcnt vmcnt(" #n ")" ::: "memory")

template <int MODE>
DI void attn_issue(const char* ktile, const char* vtile, int tid, LAS unsigned char* stage, int w) {
    using C = AttnCfg<MODE>;
    asm volatile("" : "+v"(tid));
    const int krow_s = tid / C::PPR, kpc_s = tid % C::PPR;
    const int kswz_s = (C::PPR == 16) ? (krow_s & 15) : ((krow_s >> 1) & 7);
    const unsigned koff = (unsigned)(krow_s * C::KW * 2 + ((kpc_s ^ kswz_s) << 4));
    const int vrow_s = tid >> 3, vpc_s = tid & 7;
    const unsigned voff = (unsigned)(vrow_s * T * 2 + ((vpc_s ^ ((vrow_s >> 1) & 7)) << 4));
#pragma unroll
    for (int i = 0; i < C::NIK; ++i)
        __builtin_amdgcn_global_load_lds((const unsigned*)(ktile + (koff + (unsigned)(i * (512 / C::PPR) * C::KW * 2))), (LAS unsigned*)(stage + i * 8192 + w * 1024), 16, 0, 0);
#pragma unroll
    for (int i = 0; i < C::NIV; ++i)
        __builtin_amdgcn_global_load_lds((const unsigned*)(vtile + (voff + (unsigned)(i * 64 * T * 2))), (LAS unsigned*)(stage + C::KT_BYTES + i * 8192 + w * 1024), 16, 0, 0);
}

template <int MODE>
DI void attn_phase(LAS unsigned char* lds, const bf16_t* Q, const bf16_t* Kb, const bf16_t* Vt, bf16_t* O,
                   const float* lamp, const float* subln, float lam_init, const float* rpb, const float* sink, const int tid, const int bid) {
    using C = AttnCfg<MODE>;
    constexpr int NC = C::NC, NDT = C::NDT;
    const int w = __builtin_amdgcn_readfirstlane(tid >> 6);
    const int G = gridDim.x;
    constexpr int nlat = C::NH * 64, ntotal = nlat + C::NH;
    LAS float* rpbL = (LAS float*)(lds + C::NSTG * C::STAGE);
    float lam_full = 0.f;
    if (MODE == 0) { const int lane = tid & 63; float p0 = lamp[lane] * lamp[64 + lane], p1 = lamp[128 + lane] * lamp[192 + lane]; p0 = wave_sum(p0, lane); p1 = wave_sum(p1, lane); lam_full = expf(p0) - expf(p1) + lam_init; lam_full = __builtin_bit_cast(float, __builtin_amdgcn_readfirstlane(__builtin_bit_cast(int, lam_full))); }
    lam_init = __builtin_bit_cast(float, __builtin_amdgcn_readfirstlane(__builtin_bit_cast(int, lam_init)));

    for (int u = bid; u < ntotal; u += G) {
        int tidu = tid; asm volatile("" : "+v"(tidu));
        const int lane = tidu & 63, r = lane & 31, hh = lane >> 5;
        const int ky = hh ^ ((C::PPR == 16) ? (r & 15) : ((r >> 1) & 7));
        const int vy = hh ^ ((r >> 1) & 7);
        const unsigned krb = (unsigned)(r * C::RB), vrb = (unsigned)(C::KT_BYTES + r * 128);
        const bool isctx = u >= nlat;
        const int head = isctx ? u - nlat : (u & (C::NH - 1));
        const int qb = isctx ? 0 : u / C::NH;
        const int tq = (isctx ? 0 : NCTX + 256 * qb) + 32 * w + r;
        const int qcol = MODE == 0 ? head * 128 : head * 64;
        const int kcol = MODE == 0 ? head * 128 : (MODE == 1 ? head * 64 : (head >> 2) * 64);
        const int vrow = kcol;
        int ntile = 4, b_lo = 0;
        if (!isctx) {
            if (MODE == 0) ntile = T / 64;
            else if (MODE == 2) { const int plo = (256 * qb - 128) < 0 ? 0 : 256 * qb - 128, phi = (256 * qb + 384) > SEQ ? SEQ : 256 * qb + 384; b_lo = plo; ntile = 4 + (phi - plo) / 64; }
            else { int rlo = 4 * qb - 4; rlo = rlo < 0 ? 0 : (rlo > 248 ? 248 : rlo); int rhi = 4 * qb - 1; rhi = rhi < 0 ? 0 : (rhi > 248 ? 248 : rhi); rhi += 8; b_lo = rlo; ntile = 4 + (rhi - rlo); }
        }
#define TOK0(it) (MODE == 0 ? 64 * (it) : ((it) < 4 ? 64 * (it) : (MODE == 2 ? NCTX + b_lo + 64 * ((it) - 4) : NCTX + 64 * (b_lo + (it) - 4))))
        bf16x8 qf[NC][4];
#pragma unroll
        for (int mc = 0; mc < NC; ++mc)
#pragma unroll
            for (int ks = 0; ks < 4; ++ks) qf[mc][ks] = *(const bf16x8*)(Q + (size_t)tq * D + qcol + 64 * mc + 16 * ks + 8 * hh);
        LAS unsigned char* qpark = lds + C::NSTG * C::STAGE + w * 4096 + lane * 16;
        if (MODE == 0) {
#pragma unroll
            for (int ks = 0; ks < 4; ++ks) *(LAS bf16x8*)(qpark + ks * 1024) = qf[NC - 1][ks];
        }
        if (MODE == 1) { if (tid < 465) rpbL[tid] = rpb[head * 465 + tid] * LOG2E; }

        f32x16 Oa[NC][NDT];
#pragma unroll
        for (int mc = 0; mc < NC; ++mc)
#pragma unroll
            for (int dt = 0; dt < NDT; ++dt)
#pragma unroll
                for (int i = 0; i < 16; ++i) Oa[mc][dt][i] = 0.f;
        float mrun[NC], lrun[NC];
#pragma unroll
        for (int mc = 0; mc < NC; ++mc) { mrun[mc] = -1e30f; lrun[mc] = 0.f; }

        const char* kb0 = (const char*)(Kb + kcol); const char* vb0 = (const char*)(Vt + (size_t)vrow * T);
        asm volatile("s_waitcnt vmcnt(0) lgkmcnt(0)" ::: "memory");
        { int tk = TOK0(0); asm volatile("" : "+s"(tk)); attn_issue<MODE>(kb0 + (size_t)tk * C::KW * 2, vb0 + (size_t)tk * 2, tid, lds, w); }
        if (ntile > 1) { int tk = TOK0(1); asm volatile("" : "+s"(tk)); attn_issue<MODE>(kb0 + (size_t)tk * C::KW * 2, vb0 + (size_t)tk * 2, tid, lds + C::STAGE, w); }

        const int qpl = 256 * qb + 32 * w + r;
        const int qw0 = 256 * qb + 32 * w;
        const int qr = qpl >> 6, qc = qpl & 63;
        int kr0 = qr - 4; kr0 = kr0 < 0 ? 0 : (kr0 > 248 ? 248 : kr0);
        int kc0 = qc - 8; kc0 = kc0 < 0 ? 0 : (kc0 > 48 ? 48 : kc0);

        int stg = 0;
        for (int it = 0; it < ntile; ++it) {
            if (it + 1 < ntile) { if (C::NL == 4) ATT_WAIT_V(4); else ATT_WAIT_V(2); } else ATT_WAIT_V(0);
            __builtin_amdgcn_s_barrier();
            const int s2 = stg == 0 ? 2 : stg - 1;
            LAS unsigned char* sb = lds + stg * C::STAGE;
            stg = stg == 2 ? 0 : stg + 1;
            const bool masked = (MODE != 0) && !isctx && it >= 4;
            bool tile_on = true; int kp0 = 0, krow_t = 0;
            if (MODE == 2 && masked) { kp0 = b_lo + 64 * (it - 4); tile_on = !(kp0 > qw0 + 31 + 128 || kp0 + 63 < qw0 - 128); }
            if (MODE == 1 && masked) { krow_t = b_lo + (it - 4); tile_on = (krow_t >= kr0) && (krow_t < kr0 + 8); }
            tile_on = __builtin_amdgcn_readfirstlane(tile_on ? 1 : 0) != 0;
            bf16x8 kf[NC][4], vf[2][NDT];
#define LOAD_KF(t_, mc) do { _Pragma("unroll") for (int ks = 0; ks < 4; ++ks) \
                kf[mc][ks] = *(const LAS bf16x8*)(sb + (krb + (unsigned)((t_) * 32 * C::RB)) + (unsigned)(((8 * (mc) + 2 * ks) ^ ky) << 4)); } while (0)
#define LOAD_VF(t_) do { _Pragma("unroll") for (int s = 0; s < 2; ++s) _Pragma("unroll") for (int dt = 0; dt < NDT; ++dt) \
                vf[s][dt] = *(const LAS bf16x8*)(sb + (vrb + (unsigned)(dt * 32 * 128)) + (unsigned)(((4 * (t_) + 2 * s) ^ vy) << 4)); } while (0)
            LOAD_KF(0, 0);
#pragma unroll
            for (int t = 0; t < 2; ++t) {
                bool sub_on = tile_on;
                if (MODE == 2 && masked) { const int ks0 = kp0 + 32 * t; sub_on = sub_on && !(ks0 > qw0 + 31 + 128 || ks0 + 31 < qw0 - 128); }
                bf16x8 P[NC][2];
                f32x16 S[NC];
                __builtin_amdgcn_sched_barrier(0);
                if (sub_on) {
                    bf16x8 qp[4];
                    if (MODE == 0) {
                        LOAD_KF(t, NC - 1);
#pragma unroll
                        for (int ks = 0; ks < 4; ++ks) qp[ks] = *(const LAS bf16x8*)(qpark + ks * 1024);
                    }
#pragma unroll
                    for (int mc = 0; mc < NC; ++mc) {
#pragma unroll
                        for (int i = 0; i < 16; ++i) S[mc][i] = 0.f;
#pragma unroll
                        for (int ks = 0; ks < 4; ++ks) S[mc] = MFMA32(kf[mc][ks], (MODE == 0 && mc == 1) ? qp[ks] : qf[0][ks], S[mc]);
                    }
                }
                __builtin_amdgcn_sched_barrier(0);
                LOAD_VF(t);
                if (sub_on) {
                    float mxv[NC];
#pragma unroll
                    for (int mc = 0; mc < NC; ++mc) {
                        if (MODE == 2 && masked && !(kp0 + 32 * t >= qw0 + 31 - 128 && kp0 + 32 * t + 31 <= qw0 + 128)) {
#pragma unroll
                            for (int i = 0; i < 16; ++i) { const int kp = kp0 + 32 * t + crow(i, hh); const int dd = qpl - kp; const bool ok = (dd <= 128) && (dd >= -128); S[mc][i] = ok ? S[mc][i] : -1e30f; }
                        }
                        if (MODE == 1 && masked) {
                            const LAS float* pb = rpbL + ((krow_t - qr + 7) * 31 + 15 - qc + 4 * hh);
#pragma unroll
                            for (int i = 0; i < 16; ++i) { const int kcl = 32 * t + (i & 3) + 8 * (i >> 2); const bool ok = (unsigned)(kcl + 4 * hh - kc0) < 16u;
                                const float bv = pb[kcl]; S[mc][i] = ok ? S[mc][i] + bv : -1e30f; }
                        }
                        float mx = fmaxf(S[mc][0], S[mc][1]);
#pragma unroll
                        for (int i = 2; i < 16; i += 2) mx = max3f(mx, S[mc][i], S[mc][i + 1]);
                        mxv[mc] = mx;
                    }
#pragma unroll
                    for (int mc = 0; mc < NC; ++mc) {
                        const float mx = xhalf_max(mxv[mc]);
                        if (__any(mx > mrun[mc] + 6.f)) {
                            const float mn = fmaxf(mrun[mc], mx); const float al = __builtin_amdgcn_exp2f(mrun[mc] - mn); mrun[mc] = mn; lrun[mc] *= al;
#pragma unroll
                            for (int dt = 0; dt < NDT; ++dt)
#pragma unroll
                                for (int i = 0; i < 16; ++i) Oa[mc][dt][i] *= al;
                        }
                    }
                }
                __builtin_amdgcn_sched_barrier(0);
#define SM_EXP(mc) do { const f32x2 m2 = {mrun[mc], mrun[mc]}; f32x2 ps2 = {0.f, 0.f}; unsigned pk[8]; \
                    _Pragma("unroll") for (int i = 0; i < 8; ++i) { f32x2 d = {S[mc][2 * i], S[mc][2 * i + 1]}; d = d - m2; f32x2 e; e.x = __builtin_amdgcn_exp2f(d.x); e.y = __builtin_amdgcn_exp2f(d.y); ps2 += e; pk[i] = cvtpk(e.x, e.y); } \
                    lrun[mc] += ps2.x + ps2.y; \
                    _Pragma("unroll") for (int s = 0; s < 2; ++s) { u32x4 q4; q4.x = pk[4 * s]; q4.y = pk[4 * s + 1]; q4.z = pk[4 * s + 2]; q4.w = pk[4 * s + 3]; P[mc][s] = __builtin_bit_cast(bf16x8, q4); } } while (0)
#define PV_MM(mc) do { _Pragma("unroll") for (int s = 0; s < 2; ++s) _Pragma("unroll") for (int dt = 0; dt < NDT; ++dt) Oa[mc][dt] = MFMA32(vf[s][dt], P[mc][s], Oa[mc][dt]); } while (0)
                if (sub_on) {
                    SM_EXP(0);
                    __builtin_amdgcn_sched_barrier(0);
                    if (NC == 2) {
                        PV_MM(0);
                        SM_EXP(NC - 1);
#pragma unroll
                        for (int g = 0; g < 2 * NDT; ++g) { __builtin_amdgcn_sched_group_barrier(0x008, 1, 0); __builtin_amdgcn_sched_group_barrier(0x002, 4, 0); __builtin_amdgcn_sched_group_barrier(0x400, 2, 0); }
                        __builtin_amdgcn_sched_barrier(0);
                        if (t == 0) LOAD_KF(1, 0);
                        PV_MM(NC - 1);
                    } else {
                        if (t == 0) LOAD_KF(1, 0);
                        PV_MM(0);
                    }
                } else { if (t == 0) LOAD_KF(1, 0); }
                __builtin_amdgcn_sched_barrier(0);
            }
            if (it + 2 < ntile) { int tk = TOK0(it + 2); asm volatile("" : "+s"(tk));
                attn_issue<MODE>(kb0 + (size_t)tk * C::KW * 2, vb0 + (size_t)tk * 2, tid, lds + s2 * C::STAGE, w); }
#undef SM_EXP
#undef PV_MM
#undef LOAD_KF
#undef LOAD_VF
        }
        __builtin_amdgcn_s_barrier();
        int tid3 = tid; asm volatile("" : "+v"(tid3));
        const int tq3 = (isctx ? 0 : NCTX + 256 * qb) + (tid3 >> 6) * 32 + (tid3 & 31);
        bf16_t* orow = O + (size_t)tq3 * D + qcol;
        if (MODE == 0) {
            const float l0 = lrun[0] + shfl_xor_l(lrun[0], 32, lane), l1 = lrun[NC - 1] + shfl_xor_l(lrun[NC - 1], 32, lane);
            const float i0 = 1.f / l0, i1 = lam_full / l1; float ss = 0.f;
#pragma unroll
            for (int dt = 0; dt < NDT; ++dt)
#pragma unroll
                for (int i = 0; i < 16; ++i) { const float o = Oa[0][dt][i] * i0 - Oa[NC - 1][dt][i] * i1; Oa[0][dt][i] = o; ss += o * o; }
            ss += shfl_xor_l(ss, 32, lane);
            float li_ = lam_init; asm volatile("" : "+s"(li_));
            const float rn = (1.f / sqrtf(ss * (1.f / 128.f) + NORM_EPS)) * (1.f - li_);
#pragma unroll
            for (int dt = 0; dt < NDT; ++dt)
#pragma unroll
                for (int g = 0; g < 4; ++g) { const int dvb = 32 * dt + 8 * g + 4 * hh; const f32x4 sg = *(const f32x4*)(subln + dvb);
                    u32x2 wv; wv.x = cvtpk(Oa[0][dt][4 * g] * rn * sg[0], Oa[0][dt][4 * g + 1] * rn * sg[1]); wv.y = cvtpk(Oa[0][dt][4 * g + 2] * rn * sg[2], Oa[0][dt][4 * g + 3] * rn * sg[3]);
                    *(u32x2*)(orow + dvb) = wv; }
        } else {
            float lt = lrun[0] + shfl_xor_l(lrun[0], 32, lane); float inv;
            if (MODE == 2) { const float s2 = sink[head] * LOG2E; const float mf = fmaxf(mrun[0], s2); const float al = __builtin_amdgcn_exp2f(mrun[0] - mf); lt = lt * al + __builtin_amdgcn_exp2f(s2 - mf); inv = al / lt; }
            else inv = 1.f / lt;
#pragma unroll
            for (int dt = 0; dt < NDT; ++dt)
#pragma unroll
                for (int g = 0; g < 4; ++g) { const int dvb = 32 * dt + 8 * g + 4 * hh;
                    u32x2 wv; wv.x = cvtpk(Oa[0][dt][4 * g] * inv, Oa[0][dt][4 * g + 1] * inv); wv.y = cvtpk(Oa[0][dt][4 * g + 2] * inv, Oa[0][dt][4 * g + 3] * inv);
                    *(u32x2*)(orow + dvb) = wv; }
        }
#undef TOK0
    }
}

#define XB_TMO      128
#define XB_XCNT(j)  (256  + 64 * (j))
#define XB_XSUB(j)  (1280 + 64 * (j))
#define XB_XGEN(j)  (2304 + 64 * (j))
#define XB_TOP      3328
#define XB_TOPGEN   3392
#define XCD_BAR_WORDS 3456
#define XB_SPIN_CAP (1u << 18)

__device__ __forceinline__ unsigned xb_ld(unsigned* p)              { return __hip_atomic_load(p, __ATOMIC_RELAXED, __HIP_MEMORY_SCOPE_AGENT); }
__device__ __forceinline__ unsigned xb_add(unsigned* p, unsigned v) { return __hip_atomic_fetch_add(p, v, __ATOMIC_RELAXED, __HIP_MEMORY_SCOPE_AGENT); }
__device__ __forceinline__ unsigned xb_xcc_id() { return (unsigned)__builtin_amdgcn_s_getreg((3 << 11) | 20) & 0xFu; }
#define XB_SPIN(cond, bar) do { unsigned _sp = 0; while (cond) { __builtin_amdgcn_s_sleep(1); \
    if ((++_sp & 255u) == 0u) { if (xb_ld(&(bar)[XB_TMO])) break; if (_sp > XB_SPIN_CAP) { atomicAdd(&(bar)[XB_TMO], 1u); break; } } } } while (0)

struct XcdBarrier {
    unsigned* bar; unsigned x;
    volatile LAS unsigned* st;
};

__device__ __forceinline__ XcdBarrier xcd_barrier_post(unsigned* bar, volatile LAS unsigned* st) {
    XcdBarrier b; b.bar = bar; b.x = xb_xcc_id(); b.st = st;
    if (threadIdx.x == 0) (void)xb_add(&bar[XB_XCNT(b.x)], 1u);
    return b;
}
__device__ __forceinline__ void xcd_barrier_complete(unsigned* bar, unsigned x, unsigned& nloc, unsigned& nx) {
    const unsigned G = gridDim.x * gridDim.y * gridDim.z;
    unsigned sum, cnt, mine, sp = 0u;
    for (;;) {
        sum = 0u; cnt = 0u; mine = 0u;
#pragma unroll
        for (unsigned j = 0; j < 16; ++j) { const unsigned c = xb_ld(&bar[XB_XCNT(j)]); sum += c; cnt += (c > 0u) ? 1u : 0u; mine = (j == x) ? c : mine; }
        if (sum == G) break;
        __builtin_amdgcn_s_sleep(1);
        if ((++sp & 255u) == 0u) { if (xb_ld(&bar[XB_TMO])) break; if (sp > XB_SPIN_CAP) { atomicAdd(&bar[XB_TMO], 1u); break; } }
    }
    nloc = mine > 0u ? mine : 1u; nx = cnt > 0u ? cnt : 1u;
}

__device__ __forceinline__ void xcd_barrier(const XcdBarrier& b) {
    asm volatile("s_waitcnt vmcnt(0)" ::: "memory");
    __syncthreads();
    if (threadIdx.x == 0) {
        unsigned* bar = b.bar;
        __builtin_amdgcn_s_waitcnt(0);
        unsigned nloc = b.st[0], nx = b.st[1];
        if (nloc == 0u) { xcd_barrier_complete(bar, b.x, nloc, nx); b.st[0] = nloc; b.st[1] = nx; }
        const unsigned old = xb_add(&bar[XB_XSUB(b.x)], 1u);
        const unsigned gen = old / nloc;
        if (old + 1u == (gen + 1u) * nloc) {
            __builtin_amdgcn_fence(__ATOMIC_RELEASE, "agent");
            asm volatile("s_waitcnt vmcnt(0)" ::: "memory");
            const unsigned og = xb_add(&bar[XB_TOP], 1u);
            const unsigned tg = og / nx;
            if (og + 1u == (tg + 1u) * nx) xb_add(&bar[XB_TOPGEN], 1u);
            else XB_SPIN(xb_ld(&bar[XB_TOPGEN]) == tg, bar);
            __builtin_amdgcn_fence(__ATOMIC_ACQUIRE, "agent");
            xb_add(&bar[XB_XGEN(b.x)], 1u);
            asm volatile("s_waitcnt vmcnt(0)" ::: "memory");
        } else {
            XB_SPIN(xb_ld(&bar[XB_XGEN(b.x)]) == gen, bar);
            __builtin_amdgcn_fence(__ATOMIC_ACQUIRE, "agent");
            asm volatile("s_waitcnt vmcnt(0)" ::: "memory");
        }
    }
    __syncthreads();
}

constexpr int LDS_BAR_OFF = 131072 + 64;
constexpr int LDS_BYTES = 135168;
constexpr int N_PHASES = 2 + 7 * DEPTH;

__global__ void __launch_bounds__(512) fwd_megakernel(Args a) {
    extern __shared__ __attribute__((aligned(16))) unsigned char lds_raw[];
    LAS unsigned char* lds = (LAS unsigned char*)lds_raw;
    cg::grid_group grid = cg::this_grid();
    const int G = gridDim.x;
    const int wave_id_ = __builtin_amdgcn_readfirstlane((int)threadIdx.x >> 6);
    volatile LAS unsigned* bar_st = (volatile LAS unsigned*)(lds + LDS_BAR_OFF);
    if (threadIdx.x < 2) bar_st[threadIdx.x] = 0u;
    __syncthreads();
    const XcdBarrier xbar = xcd_barrier_post((unsigned*)(a.ws + WS_BAR), bar_st);
    bf16_t* H = (bf16_t*)(a.ws + WS_H); bf16_t* Qb = (bf16_t*)(a.ws + WS_Q); bf16_t* Kb = (bf16_t*)(a.ws + WS_K); bf16_t* Vt = (bf16_t*)(a.ws + WS_VT);
    bf16_t* ACT = (bf16_t*)(a.ws + WS_ACT); bf16_t* Y = (bf16_t*)(a.ws + WS_Y);
    for (int ph = a.ph_lo; ph < a.ph_hi; ++ph) {
        unsigned ones_ = ~0u; asm volatile("" : "+s"(ones_));
        int tid = wave_id_ * 64 + (int)__builtin_amdgcn_mbcnt_hi(ones_, __builtin_amdgcn_mbcnt_lo(ones_, 0u)); asm volatile("" : "+v"(tid));
        int c = blockIdx.x; asm volatile("" : "+s"(c));
        if (ph == 0) phase_p0(a, lds, tid, c);
        else if (ph == 1) rowpass<0>(a, 0, tid, c);
        else {
            const int li = (ph - 2) / 7, sub = (ph - 2) % 7, mixer = li % 3, j = li / 3;
            const bf16_t* wt = (const bf16_t*)(a.ws + WS_WT) + (size_t)li * LWT;
            if (sub == 0) {
                const int kw = mixer == 2 ? 256 : 1024;
                MSched S; S.init(H, wt + WT_QKV, T / 256, (1024 + kw) / 256, wt + WT_QKV + (size_t)(1024 + kw) * 1024, H, kw / 256, T / 256, 1024, G, c);
                EpiQKV E{Qb, Kb, Vt, kw, mixer != 1 ? 1 : 0};
                pg8::gemm_phase<EpiQKV, MSched, true, true>(lds, 1024, 1024, S, E, tid);
            } else if (sub == 1) {
                if (mixer == 0) attn_phase<0>(lds, Qb, Kb, Vt, H, a.in[11] + j * 256, a.in[12] + j * 128, 0.8f - 0.6f * expf(-0.3f * (float)li), nullptr, nullptr, tid, c);
                else if (mixer == 1) attn_phase<1>(lds, Qb, Kb, Vt, H, nullptr, nullptr, 0.f, a.in[15], nullptr, tid, c);
                else attn_phase<2>(lds, Qb, Kb, Vt, H, nullptr, nullptr, 0.f, nullptr, a.in[18], tid, c);
            } else if (sub == 2) {
                { KSched S{H, wt + WT_O, 4, 1024, G, c}; EpiYP E{(float*)(a.ws + WS_YP)};
                  pg8::gemm_phase<EpiYP, KSched, true, true>(lds, 256, 1024, S, E, tid); }
                MSched S; S.init(H + (size_t)NCTX * 1024, wt + WT_O, SEQ / 256, 4, nullptr, nullptr, 0, 0, 1024, G, c);
                EpiY E{Y + (size_t)NCTX * D};
                pg8::gemm_phase<EpiY, MSched, true, true>(lds, 1024, 1024, S, E, tid);
            } else if (sub == 3) rowpass<1>(a, li, tid, c);
            else if (sub == 4) {
                MSched S; S.init(H, wt + WT_13, T / 256, FF2 / 256, nullptr, nullptr, 0, 0, 1024, G, c);
                EpiSwi E{ACT};
                pg8::gemm_phase<EpiSwi, MSched, true, true>(lds, 1024, 1024, S, E, tid);
            } else if (sub == 5) {
                { KSched S{ACT, wt + WT_2, 11, FF, G, c}; EpiYP E{(float*)(a.ws + WS_YP)};
                  pg8::gemm_phase<EpiYP, KSched, true, true>(lds, 256, FF, S, E, tid); }
                MSched S; S.init(ACT + (size_t)NCTX * FF, wt + WT_2, SEQ / 256, 4, nullptr, nullptr, 0, 0, FF, G, c);
                EpiY E{Y + (size_t)NCTX * D};
                pg8::gemm_phase<EpiY, MSched, true, true>(lds, FF, FF, S, E, tid);
            } else rowpass<2>(a, li, tid, c);
        }
        if (ph + 1 < a.ph_hi) { if (ph == a.ph_lo) grid.sync(); else xcd_barrier(xbar); }
    }
}

extern "C" void kernel_launch(void* const* d_in, const int* in_sizes, int n_in, void* d_out, int out_size, void* d_ws, size_t ws_size, hipStream_t stream) {
    static int grid = 0;
    if (grid == 0) {
        if (n_in != 19 || out_size != SEQ * D || ws_size < WS_END) { fprintf(stderr, "kernel_launch: unexpected shapes (n_in %d, out %d, ws %zu)\n", n_in, out_size, ws_size); grid = -1; return; }
        int dev = 0, cus = 0, per_cu = 0;
        (void)hipGetDevice(&dev);
        (void)hipDeviceGetAttribute(&cus, hipDeviceAttributeMultiprocessorCount, dev);
        (void)hipFuncSetAttribute((const void*)fwd_megakernel, hipFuncAttributeMaxDynamicSharedMemorySize, LDS_BYTES);
        (void)hipOccupancyMaxActiveBlocksPerMultiprocessor(&per_cu, (const void*)fwd_megakernel, 512, LDS_BYTES);
        if (per_cu < 1) per_cu = 1;
        grid = cus * per_cu;
        (void)hipGetLastError();
    }
    if (grid < 0) return;
    (void)hipMemsetAsync((char*)d_ws + WS_BAR, 0, XCD_BAR_WORDS * 4, stream);
    Args a{};
    for (int i = 0; i < 19; ++i) a.in[i] = (const float*)d_in[i];
    a.out = (float*)d_out; a.ws = (unsigned char*)d_ws; a.ph_lo = 0; a.ph_hi = N_PHASES;
    void* args[] = {&a};
    hipError_t e = hipLaunchCooperativeKernel((const void*)fwd_megakernel, dim3(grid), dim3(512), args, LDS_BYTES, stream);
    if (e != hipSuccess) fprintf(stderr, "cooperative launch failed: %s (grid %d)\n", hipGetErrorString(e), grid);
}
```

```cpp
#include <hip/hip_runtime.h>
#include <hip/hip_cooperative_groups.h>
#include <cstdio>
#include <cstdint>
namespace cg = cooperative_groups;

#define LAS __attribute__((address_space(3)))
#define DI __device__ __forceinline__
typedef unsigned short bf16_t;
typedef short bf16x8 __attribute__((ext_vector_type(8)));
typedef short s16x4 __attribute__((ext_vector_type(4)));
typedef float f32x2 __attribute__((ext_vector_type(2)));
typedef float f32x4 __attribute__((ext_vector_type(4)));
typedef float f32x16 __attribute__((ext_vector_type(16)));
typedef unsigned u32x2 __attribute__((ext_vector_type(2)));
typedef unsigned u32x4 __attribute__((ext_vector_type(4)));
typedef __bf16 bf16x2_t __attribute__((ext_vector_type(2)));

constexpr int NCTX = 256, SEQ = 16384, T = NCTX + SEQ, D = 1024, FF = 2816, FF2 = 5632, DEPTH = 4;
constexpr float LOG2E = 1.4426950408889634f;
constexpr float QSCALE = 0.125f * LOG2E;
constexpr float NORM_EPS = 1e-6f;

DI unsigned cvtpk(float lo, float hi) { f32x2 v = {lo, hi}; bf16x2_t b = __builtin_convertvector(v, bf16x2_t); return __builtin_bit_cast(unsigned, b); }
DI float shfl_xor_l(float v, int o, int lane) { return __builtin_bit_cast(float, __builtin_amdgcn_ds_bpermute((lane ^ o) << 2, __builtin_bit_cast(int, v))); }
DI float xhalf_max(float v) { float a = v, b = v; asm volatile("s_nop 1\n\tv_permlane32_swap_b32 %0, %1" : "+v"(a), "+v"(b)); return fmaxf(a, b); }
DI float wave_sum(float v, int lane) {
#pragma unroll
    for (int o = 1; o < 64; o <<= 1) v += shfl_xor_l(v, o, lane);
    return v;
}
#define LDS_WAIT() asm volatile("s_waitcnt lgkmcnt(0)" ::: "memory")

namespace pg8 {
#define PG8_LAS __attribute__((address_space(3)))
constexpr int BM = 256, BK = 64, HALF = 128, HTB = HALF * BK * 2  , STAGE_BYTES = 8 * HTB, NXCD = 8, WGM = 8;

__host__ __device__ __forceinline__ int lds_byte(int r, int c) { const int st = (r >> 4) * 2 + (c >> 5), rr = r & 15, cc = c & 31, ob = rr * 64 + cc * 2; return st * 1024 + (ob ^ (((ob >> 9) & 1) << 5)); }
__host__ __device__ __forceinline__ void stage_rc(int b, int& R, int& C) { const int st = b / 1024, sb = b % 1024, swz = sb ^ (((sb >> 9) & 1) << 5); R = (st >> 1) * 16 + swz / 64; C = (st & 1) * 32 + (swz % 64) / 2; }
__host__ __device__ __forceinline__ int perm32(int rho) { const int n = rho >> 4, i = rho & 15; return 8 * (i >> 2) + 4 * n + (i & 3); }

struct Unit { int pm, pn, g; const char* a; const char* b; };
template <class Epi, class Sched, bool ALIGN_EPI = false, bool SP2 = false>
__device__ __forceinline__ void gemm_phase(PG8_LAS unsigned char* lds, const int K, const int ldk, const Sched& S, const Epi& E, const int tid) {
    const int wid = __builtin_amdgcn_readfirstlane(tid >> 6), lane = tid & 63, wr = wid >> 2, wc = wid & 3, fr = lane & 15, fq = lane >> 4;
    const int nt = K / BK;
    unsigned voffA[2], voffB[2];
#pragma unroll
    for (int i = 0; i < 2; ++i) { int R, C; stage_rc(tid * 16 + i * 8192, R, C); const int Rb = Epi::PERM ? ((R & ~31) + perm32(R & 31)) : R;
        voffA[i] = (unsigned)(R * ldk + C) * 2u; voffB[i] = (unsigned)(Rb * ldk + C) * 2u; }
    const size_t kstep = (size_t)(BK * 2);
    const size_t hstep = (size_t)HALF * ldk * 2;
    const unsigned ldsw = (unsigned)wid * 1024u;
    const int aoff = lds_byte(wr * 64 + fr, fq * 8), boff = lds_byte(wc * 32 + fr, fq * 8);
#define PG8_SA(b, h) (((b) * 2 + (h)) * HTB)
#define PG8_SB(b, h) ((4 + (b) * 2 + (h)) * HTB)
#define PG8_STAGE(bufoff, gbase, voff) do { _Pragma("unroll") for (int _i = 0; _i < 2; ++_i) \
        __builtin_amdgcn_global_load_lds((const unsigned*)((const char*)(gbase) + (voff)[_i]), (PG8_LAS unsigned*)(lds + (bufoff) + ldsw + _i * 8192), 16, 0, 0); } while (0)
#define PG8_LDA(dst, b, h) do { _Pragma("unroll") for (int m = 0; m < 4; ++m) _Pragma("unroll") for (int k = 0; k < 2; ++k) dst[m][k] = *(const PG8_LAS bf16x8*)(lds + PG8_SA(b, h) + aoff + m * 2048 + k * 1024); } while (0)
#define PG8_LDB(dst, b, h) do { _Pragma("unroll") for (int n = 0; n < 2; ++n) _Pragma("unroll") for (int k = 0; k < 2; ++k) dst[n][k] = *(const PG8_LAS bf16x8*)(lds + PG8_SB(b, h) + boff + n * 2048 + k * 1024); } while (0)
#define PG8_MMA(ai, bj, At, Bt) do { __builtin_amdgcn_s_setprio(1); _Pragma("unroll") for (int m = 0; m < 4; ++m) _Pragma("unroll") for (int n = 0; n < 2; ++n) _Pragma("unroll") for (int k = 0; k < 2; ++k) \
        acc[ai][bj][m][n] = __builtin_amdgcn_mfma_f32_16x16x32_bf16(Bt[n][k], At[m][k], acc[ai][bj][m][n], 0, 0, 0); __builtin_amdgcn_s_setprio(0); } while (0)
#define PG8_WAIT_V(n) asm volatile("s_waitcnt vmcnt(" #n ")" ::: "memory")
#define PG8_WAIT_L(n) asm volatile("s_waitcnt lgkmcnt(" #n ")" ::: "memory")
#define PG8_BAR __builtin_amdgcn_s_barrier()
#define PG8_SCHED __builtin_amdgcn_sched_barrier(0)
    Unit cur, nxt; int ui = 0;
    if (!S.next(0, cur)) return;
    f32x4 acc[2][2][4][2];
#pragma unroll
    for (int a = 0; a < 2; ++a)
#pragma unroll
        for (int b = 0; b < 2; ++b)
#pragma unroll
            for (int m = 0; m < 4; ++m)
#pragma unroll
                for (int n = 0; n < 2; ++n) acc[a][b][m][n] = (f32x4){0.f, 0.f, 0.f, 0.f};
    bf16x8 At[4][2], B0[2][2], B1[2][2];
    const char* cA = cur.a; const char* cB = cur.b;
    S.a_ready(cur);
    if constexpr (SP2) {
        PG8_STAGE(PG8_SB(0, 0), cB, voffB); PG8_STAGE(PG8_SB(0, 1), cB + hstep, voffB); PG8_STAGE(PG8_SA(0, 0), cA, voffA); PG8_STAGE(PG8_SA(0, 1), cA + hstep, voffA);
        if (wr == 1) PG8_BAR;
        PG8_WAIT_V(2); PG8_BAR;
        PG8_STAGE(PG8_SB(1, 0), cB + kstep, voffB); PG8_STAGE(PG8_SA(1, 0), cA + kstep, voffA); PG8_STAGE(PG8_SB(1, 1), cB + hstep + kstep, voffB);
        PG8_WAIT_V(6); PG8_BAR;
    } else {
        PG8_STAGE(PG8_SB(0, 0), cB, voffB); PG8_STAGE(PG8_SA(0, 0), cA, voffA); PG8_STAGE(PG8_SB(0, 1), cB + hstep, voffB); PG8_STAGE(PG8_SA(0, 1), cA + hstep, voffA);
        if (wr == 1) PG8_BAR;
        PG8_WAIT_V(4); PG8_BAR;
        PG8_STAGE(PG8_SB(1, 0), cB + kstep, voffB); PG8_STAGE(PG8_SA(1, 0), cA + kstep, voffA); PG8_STAGE(PG8_SB(1, 1), cB + hstep + kstep, voffB);
        PG8_WAIT_V(6); PG8_BAR;
    }
    for (;;) {
        const bool has_next = S.next(ui + 1, nxt);
        const char* nA = has_next ? nxt.a : cA; const char* nB = has_next ? nxt.b : cB;
        for (int t = 0; t < nt; t += 2) {
            const bool last = (t == nt - 2);
            const char* a1 = cA + (size_t)(t + 1) * kstep;
            const char* a2 = last ? nA : cA + (size_t)(t + 2) * kstep; const char* b2 = last ? nB : cB + (size_t)(t + 2) * kstep;
            const char* a3 = a2 + kstep; const char* b3 = b2 + kstep;
            if (last && has_next) S.a_ready(nxt);
            if constexpr (SP2) {
            PG8_LDB(B0, 0, 0); PG8_LDB(B1, 0, 1); PG8_SCHED; PG8_LDA(At, 0, 0); PG8_STAGE(PG8_SA(1, 1), a1 + hstep, voffA);
            PG8_WAIT_V(8); PG8_WAIT_L(0); PG8_BAR; PG8_MMA(0, 0, At, B0); PG8_MMA(0, 1, At, B1); PG8_BAR; PG8_SCHED;
            PG8_LDA(At, 0, 1); PG8_STAGE(PG8_SB(0, 0), b2, voffB); PG8_STAGE(PG8_SB(0, 1), b2 + hstep, voffB); PG8_STAGE(PG8_SA(0, 0), a2, voffA);
            PG8_WAIT_V(8); PG8_WAIT_L(0); PG8_BAR; PG8_MMA(1, 0, At, B0); PG8_MMA(1, 1, At, B1); PG8_BAR; PG8_SCHED;
            PG8_LDB(B0, 1, 0); PG8_LDB(B1, 1, 1); PG8_SCHED; PG8_LDA(At, 1, 0); PG8_STAGE(PG8_SA(0, 1), a2 + hstep, voffA);
            PG8_WAIT_V(8); PG8_WAIT_L(0); PG8_BAR; PG8_MMA(0, 0, At, B0); PG8_MMA(0, 1, At, B1); PG8_BAR; PG8_SCHED;
            PG8_LDA(At, 1, 1); PG8_STAGE(PG8_SB(1, 0), b3, voffB); PG8_STAGE(PG8_SB(1, 1), b3 + hstep, voffB); PG8_STAGE(PG8_SA(1, 0), a3, voffA);
            PG8_WAIT_V(8); PG8_WAIT_L(0); PG8_BAR; PG8_MMA(1, 0, At, B0); PG8_MMA(1, 1, At, B1); PG8_BAR; PG8_SCHED;
            } else {
            PG8_LDB(B0, 0, 0); PG8_SCHED; PG8_LDA(At, 0, 0); PG8_STAGE(PG8_SA(1, 1), a1 + hstep, voffA);
            PG8_WAIT_L(8); PG8_BAR; PG8_WAIT_L(0); PG8_MMA(0, 0, At, B0); PG8_BAR; PG8_SCHED;
            PG8_LDB(B1, 0, 1); PG8_STAGE(PG8_SB(0, 0), b2, voffB);
            PG8_BAR; PG8_WAIT_L(0); PG8_MMA(0, 1, At, B1); PG8_BAR;
            PG8_LDA(At, 0, 1); PG8_STAGE(PG8_SA(0, 0), a2, voffA);
            PG8_BAR; PG8_WAIT_L(0); PG8_MMA(1, 0, At, B0); PG8_BAR; PG8_SCHED;
            PG8_STAGE(PG8_SB(0, 1), b2 + hstep, voffB);
            PG8_WAIT_V(6); PG8_BAR; PG8_MMA(1, 1, At, B1); PG8_BAR;
            PG8_LDB(B0, 1, 0); PG8_SCHED; PG8_LDA(At, 1, 0); PG8_STAGE(PG8_SA(0, 1), a2 + hstep, voffA);
            PG8_WAIT_L(8); PG8_BAR; PG8_WAIT_L(0); PG8_MMA(0, 0, At, B0); PG8_BAR; PG8_SCHED;
            PG8_LDB(B1, 1, 1); PG8_STAGE(PG8_SB(1, 0), b3, voffB);
            PG8_BAR; PG8_WAIT_L(0); PG8_MMA(0, 1, At, B1); PG8_BAR;
            PG8_LDA(At, 1, 1); PG8_STAGE(PG8_SA(1, 0), a3, voffA);
            PG8_BAR; PG8_WAIT_L(0); PG8_MMA(1, 0, At, B0); PG8_BAR; PG8_SCHED;
            PG8_STAGE(PG8_SB(1, 1), b3 + hstep, voffB);
            PG8_WAIT_V(6); PG8_BAR; PG8_MMA(1, 1, At, B1); PG8_BAR;
            }
        }
        if constexpr (ALIGN_EPI) { if (wr == 0) PG8_BAR; }
        if constexpr (!Epi::AFTER_DRAIN) { E(acc, cur, wr, wc, fr, fq); S.done(cur); }
        if (!has_next) break;
#pragma unroll
        for (int a = 0; a < 2; ++a)
#pragma unroll
            for (int b = 0; b < 2; ++b)
#pragma unroll
                for (int m = 0; m < 4; ++m)
#pragma unroll
                    for (int n = 0; n < 2; ++n) acc[a][b][m][n] = (f32x4){0.f, 0.f, 0.f, 0.f};
        cur = nxt; cA = nA; cB = nB; ++ui;
        if constexpr (ALIGN_EPI) { if (wr == 1) PG8_BAR; }
    }
    PG8_WAIT_V(0);
    if constexpr (!ALIGN_EPI) { if (wr == 0) PG8_BAR; }
    PG8_BAR;
    if constexpr (Epi::AFTER_DRAIN) { E.fused(acc, cur, wr, wc, fr, fq, lds, wid, lane); S.done(cur); }
#undef PG8_SA
#undef PG8_SB
#undef PG8_STAGE
#undef PG8_LDA
#undef PG8_LDB
#undef PG8_MMA
#undef PG8_WAIT_V
#undef PG8_WAIT_L
#undef PG8_BAR
#undef PG8_SCHED
}
}

struct MSched {
    const bf16_t *A0, *B0, *A1, *B1; int nM0, nN0, nM1, nN1, n0, ntot, G, c, K;
    DI void init(const bf16_t* a0, const bf16_t* b0, int m0, int nn0, const bf16_t* a1, const bf16_t* b1, int m1, int nn1, int K_, int G_, int c_) {
        A0 = a0; B0 = b0; nM0 = m0; nN0 = nn0; A1 = a1; B1 = b1; nM1 = m1; nN1 = nn1; n0 = m0 * nn0; ntot = n0 + m1 * nn1; K = K_; G = G_; c = c_;
    }
    DI bool next(int i, pg8::Unit& u) const {
        const long L = (long)i * G + c; if (L >= ntot) return false;
        int wgid = (int)L; { const int q = ntot / 8, r = ntot % 8, xcd = wgid % 8, off = wgid / 8; wgid = (xcd < r ? xcd * (q + 1) : r * (q + 1) + (xcd - r) * q) + off; }
        const int gi = wgid >= n0 ? 1 : 0; const int w = gi ? wgid - n0 : wgid;
        const int nM = gi ? nM1 : nM0, nN = gi ? nN1 : nN0;
        const int nig = 8 * nN, gid = w / nig, fm = gid * 8, gsz = (nM - fm) < 8 ? (nM - fm) : 8;
        u.pm = fm + ((w % nig) % gsz); u.pn = (w % nig) / gsz; u.g = gi;
        u.a = (const char*)(gi ? A1 : A0) + (size_t)u.pm * 256 * K * 2; u.b = (const char*)(gi ? B1 : B0) + (size_t)u.pn * 256 * K * 2;
        return true;
    }
    DI void a_ready(const pg8::Unit&) const {}
    DI void done(const pg8::Unit&) const {}
};

struct KSched {
    const bf16_t *A, *B; int ns, ldk, G, c;
    DI bool next(int i, pg8::Unit& u) const {
        const int L = i * G + c; if (L >= 4 * ns) return false;
        u.pm = 0; u.pn = L & 3; u.g = L >> 2;
        u.a = (const char*)A + (size_t)u.g * 256 * 2; u.b = (const char*)B + ((size_t)u.pn * 256 * ldk + (size_t)u.g * 256) * 2;
        return true;
    }
    DI void a_ready(const pg8::Unit&) const {}
    DI void done(const pg8::Unit&) const {}
};

struct EpiQKV {
    static constexpr bool PERM = false, AFTER_DRAIN = false;
    bf16_t* Q; bf16_t* Kb; bf16_t* Vt; int kw; int rope;
    DI void operator()(const f32x4 (&acc)[2][2][4][2], const pg8::Unit& u, int wr, int wc, int fr, int fq) const {
        asm volatile("" : "+v"(fr), "+v"(fq));
        if (u.g == 1) {
#pragma unroll
            for (int ai = 0; ai < 2; ++ai)
#pragma unroll
                for (int m = 0; m < 4; ++m) {
                    const int row = u.pm * 256 + ai * 128 + wr * 64 + m * 16 + fr;
                    bf16_t* rp = Vt + (size_t)row * T + u.pn * 256 + wc * 32 + 8 * (fq & 1) + 4 * (fq >> 1);
#pragma unroll
                    for (int bj = 0; bj < 2; ++bj)
#pragma unroll
                        for (int n = 0; n < 2; ++n) { const f32x4 v = acc[ai][bj][m][n]; u32x2 w; w.x = cvtpk(v[0], v[1]); w.y = cvtpk(v[2], v[3]); *(u32x2*)(rp + bj * 128 + n * 16) = w; }
                }
            return;
        }
        const int ct = u.pn * 256; const bool isq = ct < 1024;
        bf16_t* base = isq ? Q : Kb; const int ld = isq ? 1024 : kw; const int c0 = (isq ? ct : ct - 1024) + wc * 32 + 4 * fq;
        const float qs = isq ? QSCALE : 1.f;
        float frev[4];
#pragma unroll
        for (int e = 0; e < 4; ++e) frev[e] = exp2f(-(float)(4 * fq + e) * 0.83048202372184f) * 0.15915494309189535f;
#pragma unroll
        for (int ai = 0; ai < 2; ++ai)
#pragma unroll
            for (int m = 0; m < 4; ++m) {
                const int row = u.pm * 256 + ai * 128 + wr * 64 + m * 16 + fr;
                const bool lat = row >= NCTX; const int p = row - NCTX; const int pos = (wc & 1) ? (p & 63) : (p >> 6);
                float cs[4], sn[4];
#pragma unroll
                for (int e = 0; e < 4; ++e) { const float a = (float)pos * frev[e]; const bool rr = rope && lat; cs[e] = rr ? __builtin_amdgcn_cosf(a) : 1.f; sn[e] = rr ? __builtin_amdgcn_sinf(a) : 0.f; }
                bf16_t* rp = base + (size_t)row * ld + c0;
#pragma unroll
                for (int bj = 0; bj < 2; ++bj) {
                    const f32x4 x1 = acc[ai][bj][m][0], x2 = acc[ai][bj][m][1]; float o1[4], o2[4];
#pragma unroll
                    for (int e = 0; e < 4; ++e) { o1[e] = (x1[e] * cs[e] - x2[e] * sn[e]) * qs; o2[e] = (x2[e] * cs[e] + x1[e] * sn[e]) * qs; }
                    u32x2 w1, w2; w1.x = cvtpk(o1[0], o1[1]); w1.y = cvtpk(o1[2], o1[3]); w2.x = cvtpk(o2[0], o2[1]); w2.y = cvtpk(o2[2], o2[3]);
                    *(u32x2*)(rp + bj * 128) = w1; *(u32x2*)(rp + bj * 128 + 16) = w2;
                }
            }
    }
};
struct EpiY {
    static constexpr bool PERM = true, AFTER_DRAIN = false;
    bf16_t* Y;
    DI void operator()(const f32x4 (&acc)[2][2][4][2], const pg8::Unit& u, int wr, int wc, int fr, int fq) const {
        asm volatile("" : "+v"(fr), "+v"(fq));
#pragma unroll
        for (int ai = 0; ai < 2; ++ai)
#pragma unroll
            for (int m = 0; m < 4; ++m) {
                const int row = u.pm * 256 + ai * 128 + wr * 64 + m * 16 + fr;
                bf16_t* rp = Y + (size_t)row * D + u.pn * 256 + wc * 32 + 8 * fq;
#pragma unroll
                for (int bj = 0; bj < 2; ++bj) { const f32x4 v0 = acc[ai][bj][m][0], v1 = acc[ai][bj][m][1];
                    u32x4 w4; w4.x = cvtpk(v0[0], v0[1]); w4.y = cvtpk(v0[2], v0[3]); w4.z = cvtpk(v1[0], v1[1]); w4.w = cvtpk(v1[2], v1[3]);
                    *(u32x4*)(rp + bj * 128) = w4; }
            }
    }
};
struct EpiYP {
    static constexpr bool PERM = true, AFTER_DRAIN = false;
    float* YP;
    DI void operator()(const f32x4 (&acc)[2][2][4][2], const pg8::Unit& u, int wr, int wc, int fr, int fq) const {
        asm volatile("" : "+v"(fr), "+v"(fq));
#pragma unroll
        for (int ai = 0; ai < 2; ++ai)
#pragma unroll
            for (int m = 0; m < 4; ++m) {
                const int row = ai * 128 + wr * 64 + m * 16 + fr;
                float* rp = YP + ((size_t)u.g * 256 + row) * D + u.pn * 256 + wc * 32 + 8 * fq;
#pragma unroll
                for (int bj = 0; bj < 2; ++bj)
#pragma unroll
                    for (int n = 0; n < 2; ++n) *(f32x4*)(rp + bj * 128 + 4 * n) = acc[ai][bj][m][n];
            }
    }
};
DI float silu_mul(float g, float u) { return g * u * __builtin_amdgcn_rcpf(1.f + __builtin_amdgcn_exp2f(-g * LOG2E)); }
struct EpiSwi {
    static constexpr bool PERM = true, AFTER_DRAIN = false;
    bf16_t* ACT;
    DI void operator()(const f32x4 (&acc)[2][2][4][2], const pg8::Unit& u, int wr, int wc, int fr, int fq) const {
        asm volatile("" : "+v"(fr), "+v"(fq));
#pragma unroll
        for (int ai = 0; ai < 2; ++ai)
#pragma unroll
            for (int m = 0; m < 4; ++m) {
                const int row = u.pm * 256 + ai * 128 + wr * 64 + m * 16 + fr;
                bf16_t* rp = ACT + (size_t)row * FF + u.pn * 128 + wc * 32 + 8 * fq;
                const f32x4 g0 = acc[ai][0][m][0], g1 = acc[ai][0][m][1], u0 = acc[ai][1][m][0], u1 = acc[ai][1][m][1];
                u32x4 w;
                w.x = cvtpk(silu_mul(g0[0], u0[0]), silu_mul(g0[1], u0[1])); w.y = cvtpk(silu_mul(g0[2], u0[2]), silu_mul(g0[3], u0[3]));
                w.z = cvtpk(silu_mul(g1[0], u1[0]), silu_mul(g1[1], u1[1])); w.w = cvtpk(silu_mul(g1[2], u1[2]), silu_mul(g1[3], u1[3]));
                *(u32x4*)rp = w;
            }
    }
};

constexpr size_t MiB = 1u << 20;
constexpr size_t WS_MOD = 0;
constexpr size_t WS_BAR = 512 * 1024;
constexpr size_t WS_WT = 1 * MiB;
constexpr size_t LWT = (size_t)12544 * 1024;
constexpr size_t WT_QKV = 0, WT_O = (size_t)3072 * 1024, WT_13 = (size_t)4096 * 1024, WT_2 = (size_t)9728 * 1024;
constexpr size_t WS_X = 99 * MiB;
constexpr size_t WS_H = 164 * MiB;
constexpr size_t WS_Q = 197 * MiB;
constexpr size_t WS_K = 230 * MiB;
constexpr size_t WS_VT = 263 * MiB;
constexpr size_t WS_ACT = WS_Q;
constexpr size_t WS_Y = 296 * MiB;
constexpr size_t WS_YP = 362 * MiB;
constexpr size_t WS_END = 374 * MiB;
static_assert(WS_WT + 4 * LWT * 2 <= WS_X && WS_X + (size_t)T * D * 4 <= WS_H && WS_H + (size_t)T * D * 2 <= WS_Q && WS_Q + (size_t)T * D * 2 <= WS_K && WS_K + (size_t)T * D * 2 <= WS_VT &&
              WS_VT + (size_t)T * D * 2 <= WS_Y && WS_ACT + (size_t)T * FF * 2 <= WS_Y && WS_Y + (size_t)T * D * 4 <= WS_YP && WS_YP + (size_t)11 * 256 * D * 4 <= WS_END, "workspace map");

struct Args { const float* in[19]; float* out; unsigned char* ws; int ph_lo, ph_hi; };

DI void transpose_item(const float* W, int K, int N, bf16_t* WT, int k0, int n0, int out_row0, LAS float* scr, int lane) {
#pragma unroll 8
    for (int i = 0; i < 32; ++i) { const int kk = 2 * i + (lane >> 5); scr[kk * 33 + (lane & 31)] = W[(size_t)(k0 + kk) * N + n0 + (lane & 31)]; }
    LDS_WAIT();
    const int c = lane & 7;
#pragma unroll
    for (int j = 0; j < 4; ++j) { const int n = (lane >> 3) + 8 * j; const LAS float* s = scr + (8 * c) * 33 + n;
        u32x4 o; o.x = cvtpk(s[0 * 33], s[1 * 33]); o.y = cvtpk(s[2 * 33], s[3 * 33]); o.z = cvtpk(s[4 * 33], s[5 * 33]); o.w = cvtpk(s[6 * 33], s[7 * 33]);
        *(u32x4*)(WT + (size_t)(out_row0 + n) * K + k0 + 8 * c) = o; }
    LDS_WAIT();
}
DI float silu_f(float x) { return x / (1.f + expf(-x)); }

DI void phase_p0(const Args& a, LAS unsigned char* lds, const int tid, const int bid) {
    const int lane = tid & 63, wave = __builtin_amdgcn_readfirstlane(tid >> 6), G = gridDim.x;
    float* mod = (float*)(a.ws + WS_MOD);
    {
        LAS float* sl = (LAS float*)lds; LAS float* sc = sl + 1024; LAS float* red = sc + 1024;
        const float* cin = a.in[1]; const float* cctx = a.in[3]; const float* ada_w = a.in[4]; const float* ada_b = a.in[5];
        for (int it = bid; it < DEPTH * 24; it += G) {
            const int li = it / 24, c0 = (it % 24) * 256;
            for (int k = tid; k < 1024; k += 512) { sl[k] = silu_f(cin[k]); sc[k] = silu_f(cctx[k]); }
            __syncthreads();
            f32x4 al = {0.f, 0.f, 0.f, 0.f}, ac = {0.f, 0.f, 0.f, 0.f};
            const float* wp = ada_w + ((size_t)li * 1024 + wave * 128) * 6144 + c0 + 4 * lane;
#pragma unroll 8
            for (int k = 0; k < 128; ++k) { const f32x4 w4 = *(const f32x4*)(wp + (size_t)k * 6144); const float s1 = sl[wave * 128 + k], s2 = sc[wave * 128 + k]; al += w4 * s1; ac += w4 * s2; }
#pragma unroll
            for (int e = 0; e < 4; ++e) { red[(0 * 8 + wave) * 256 + 4 * lane + e] = al[e]; red[(1 * 8 + wave) * 256 + 4 * lane + e] = ac[e]; }
            __syncthreads();
            { const int src = tid >> 8, col = tid & 255; float s = ada_b[li * 6144 + c0 + col];
#pragma unroll
              for (int w = 0; w < 8; ++w) s += red[(src * 8 + w) * 256 + col];
              mod[(size_t)(li * 2 + src) * 6144 + c0 + col] = s; }
            __syncthreads();
        }
    }
    {
        LAS float* scr = (LAS float*)(lds + 32768 + wave * 8704);
        const int gw = bid * 8 + wave, NGW = G * 8;
        for (int li = 0; li < DEPTH; ++li) {
            const int mixer = li % 3, j = li / 3;
            const float* wqkv = mixer == 0 ? a.in[9] + (size_t)j * 1024 * 3072 : (mixer == 1 ? a.in[13] : a.in[16]);
            const float* wo = mixer == 0 ? a.in[10] + (size_t)j * 1024 * 1024 : (mixer == 1 ? a.in[14] : a.in[17]);
            const float* w13 = a.in[7] + (size_t)li * 1024 * FF2; const float* w2 = a.in[8] + (size_t)li * FF * 1024;
            const int nqkv = mixer == 2 ? 1536 : 3072;
            bf16_t* wt = (bf16_t*)(a.ws + WS_WT) + (size_t)li * LWT;
            const int I_qkv = 16 * (nqkv / 32), I_o = 16 * 32, I_13 = 16 * (FF2 / 32), I_2 = (FF / 64) * 32;
            const int NIT = I_qkv + I_o + I_13 + I_2;
            for (int it = gw; it < NIT; it += NGW) {
                int r = it;
                if (r < I_qkv) { const int nb = nqkv / 32; const int kb = r / nb, n0 = (r % nb) * 32; transpose_item(wqkv, 1024, nqkv, wt + WT_QKV, kb * 64, n0, n0, scr, lane); continue; } r -= I_qkv;
                if (r < I_o) { const int kb = r / 32, n0 = (r % 32) * 32; transpose_item(wo, 1024, 1024, wt + WT_O, kb * 64, n0, n0, scr, lane); continue; } r -= I_o;
                if (r < I_13) { const int nb = FF2 / 32; const int kb = r / nb, n0 = (r % nb) * 32;
                    const int n2 = n0 < FF ? n0 : n0 - FF; const int orow = 256 * (n2 / 128) + (n0 < FF ? 0 : 128) + (n2 % 128);
                    transpose_item(w13, 1024, FF2, wt + WT_13, kb * 64, n0, orow, scr, lane); continue; } r -= I_13;
                { const int kb = r / 32, n0 = (r % 32) * 32; transpose_item(w2, FF, 1024, wt + WT_2, kb * 64, n0, n0, scr, lane); }
            }
        }
    }
}

template <int MODE>
DI void row_body(const Args& a, int li, int row, bool last, f32x4 (&x)[4], const f32x4 (&y)[4], const f32x4 (&vg)[4], const f32x4 (&vt)[4], const f32x4 (&vgn)[4], const f32x4 (&vsh)[4], const f32x4 (&vsc)[4], int lane) {
    float* X = (float*)(a.ws + WS_X); bf16_t* H = (bf16_t*)(a.ws + WS_H);
    if (MODE != 0) {
        float ss = 0.f;
#pragma unroll
        for (int j = 0; j < 4; ++j) ss += (y[j][0] * y[j][0] + y[j][1] * y[j][1]) + (y[j][2] * y[j][2] + y[j][3] * y[j][3]);
        const float rs = 1.f / sqrtf(wave_sum(ss, lane) * (1.f / D) + NORM_EPS);
#pragma unroll
        for (int j = 0; j < 4; ++j) x[j] += vt[j] * (y[j] * rs * vg[j]);
    }
    if (last) {
#pragma unroll
        for (int j = 0; j < 4; ++j) *(f32x4*)(a.out + (size_t)(row - NCTX) * D + 4 * lane + 256 * j) = x[j];
        return;
    }
#pragma unroll
    for (int j = 0; j < 4; ++j) *(f32x4*)(X + (size_t)row * D + 4 * lane + 256 * j) = x[j];
    float s2 = 0.f;
#pragma unroll
    for (int j = 0; j < 4; ++j) s2 += (x[j][0] * x[j][0] + x[j][1] * x[j][1]) + (x[j][2] * x[j][2] + x[j][3] * x[j][3]);
    const float r2 = 1.f / sqrtf(wave_sum(s2, lane) * (1.f / D) + NORM_EPS);
#pragma unroll
    for (int j = 0; j < 4; ++j) {
        const f32x4 h = (x[j] * r2 * vgn[j]) * (vsc[j] + 1.f) + vsh[j];
        u32x2 w; w.x = cvtpk(h[0], h[1]); w.y = cvtpk(h[2], h[3]);
        *(u32x2*)(H + (size_t)row * D + 4 * lane + 256 * j) = w;
    }
}
template <int MODE>
DI void row_vectors(const Args& a, int li, int cls, bool last, f32x4 (&vg)[4], f32x4 (&vt)[4], f32x4 (&vgn)[4], f32x4 (&vsh)[4], f32x4 (&vsc)[4], int lane) {
    const float* mod = (const float*)(a.ws + WS_MOD); const float* norm_g = a.in[6];
    const int ln = MODE == 2 ? li + 1 : li;
    const float* mrow = mod + (size_t)(li * 2 + cls) * 6144;
    const float* gy = norm_g + (size_t)(li * 4 + (MODE == 1 ? 1 : 3)) * D; const float* gt = mrow + (MODE == 1 ? 2 : 5) * D;
#pragma unroll
    for (int j = 0; j < 4; ++j) { if (MODE != 0) { vg[j] = *(const f32x4*)(gy + 4 * lane + 256 * j); vt[j] = *(const f32x4*)(gt + 4 * lane + 256 * j); } else { vg[j] = (f32x4){0.f, 0.f, 0.f, 0.f}; vt[j] = vg[j]; } }
    if (!last) {
        const float* mn = mod + (size_t)(ln * 2 + cls) * 6144;
        const float* gn = norm_g + (size_t)(ln * 4 + (MODE == 1 ? 2 : 0)) * D; const float* shp = mn + (MODE == 1 ? 3 : 0) * D; const float* scp = mn + (MODE == 1 ? 4 : 1) * D;
#pragma unroll
        for (int j = 0; j < 4; ++j) { vgn[j] = *(const f32x4*)(gn + 4 * lane + 256 * j); vsh[j] = *(const f32x4*)(shp + 4 * lane + 256 * j); vsc[j] = *(const f32x4*)(scp + 4 * lane + 256 * j); }
    } else {
#pragma unroll
        for (int j = 0; j < 4; ++j) { vgn[j] = (f32x4){0.f, 0.f, 0.f, 0.f}; vsh[j] = vgn[j]; vsc[j] = vgn[j]; }
    }
}
DI void unpack_bf16x4(const u32x2 yb, f32x4& y) { y[0] = __builtin_bit_cast(float, yb.x << 16); y[1] = __builtin_bit_cast(float, yb.x & 0xffff0000u); y[2] = __builtin_bit_cast(float, yb.y << 16); y[3] = __builtin_bit_cast(float, yb.y & 0xffff0000u); }

template <int MODE>
DI void rowpass(const Args& a, int li, const int tid, const int bid) {
    const int lane = tid & 63, wave = __builtin_amdgcn_readfirstlane(tid >> 6);
    const int gw = bid * 8 + wave, NGW = gridDim.x * 8;
    const float* X = (const float*)(a.ws + WS_X); const bf16_t* Y = (const bf16_t*)(a.ws + WS_Y);
    const bool last = (MODE == 2 && li == DEPTH - 1);
    f32x4 vg[4], vt[4], vgn[4], vsh[4], vsc[4];
    int row = gw;
    if (row < NCTX) {
        if (!last) {
            row_vectors<MODE>(a, li, 1, last, vg, vt, vgn, vsh, vsc, lane);
            f32x4 x[4], y[4];
#pragma unroll
            for (int j = 0; j < 4; ++j) {
                if (MODE == 0) { x[j] = *(const f32x4*)(a.in[2] + (size_t)row * D + 4 * lane + 256 * j); y[j] = x[j]; }
                else { x[j] = *(const f32x4*)(X + (size_t)row * D + 4 * lane + 256 * j);
                    const float* yp = (const float*)(a.ws + WS_YP) + (size_t)row * D + 4 * lane + 256 * j; y[j] = *(const f32x4*)yp;
                    for (int sl = 1; sl < (MODE == 1 ? 4 : 11); ++sl) y[j] += *(const f32x4*)(yp + (size_t)sl * 256 * D); }
            }
            row_body<MODE>(a, li, row, last, x, y, vg, vt, vgn, vsh, vsc, lane);
        }
        row += NGW;
    }
    if (row >= T) return;
    row_vectors<MODE>(a, li, 0, last, vg, vt, vgn, vsh, vsc, lane);
    f32x4 xc[4]; u32x2 yc[4];
#pragma unroll
    for (int j = 0; j < 4; ++j) {
        if (MODE == 0) { xc[j] = *(const f32x4*)(a.in[0] + (size_t)(row - NCTX) * D + 4 * lane + 256 * j); yc[j] = (u32x2){0u, 0u}; }
        else { xc[j] = *(const f32x4*)(X + (size_t)row * D + 4 * lane + 256 * j); yc[j] = *(const u32x2*)(Y + (size_t)row * D + 4 * lane + 256 * j); }
    }
    for (; row < T; row += NGW) {
        const int nrow = row + NGW; const bool more = nrow < T;
        f32x4 xn[4]; u32x2 yn[4];
#pragma unroll
        for (int j = 0; j < 4; ++j) { xn[j] = xc[j]; yn[j] = yc[j]; }
        if (more) {
#pragma unroll
            for (int j = 0; j < 4; ++j) {
                if (MODE == 0) xn[j] = *(const f32x4*)(a.in[0] + (size_t)(nrow - NCTX) * D + 4 * lane + 256 * j);
                else { xn[j] = *(const f32x4*)(X + (size_t)nrow * D + 4 * lane + 256 * j); yn[j] = *(const u32x2*)(Y + (size_t)nrow * D + 4 * lane + 256 * j); }
            }
        }
        f32x4 x[4], y[4];
#pragma unroll
        for (int j = 0; j < 4; ++j) { x[j] = xc[j]; unpack_bf16x4(yc[j], y[j]); }
        row_body<MODE>(a, li, row, last, x, y, vg, vt, vgn, vsh, vsc, lane);
#pragma unroll
        for (int j = 0; j < 4; ++j) { xc[j] = xn[j]; yc[j] = yn[j]; }
    }
}

template <int MODE> struct AttnCfg {
    static constexpr int NC = MODE == 0 ? 2 : 1, DV = MODE == 0 ? 128 : 64, NDT = DV / 32, PPR = NC * 8, RB = NC * 128;
    static constexpr int KT_BYTES = 64 * RB, VT_BYTES = DV * 128, STAGE = KT_BYTES + VT_BYTES, NSTG = 3, NIK = KT_BYTES / 8192, NIV = VT_BYTES / 8192, NL = NIK + NIV;
    static constexpr int NH = MODE == 0 ? 8 : 16, KW = MODE == 2 ? 256 : 1024;
};
#define MFMA32(a, b, c) __builtin_amdgcn_mfma_f32_32x32x16_bf16((a), (b), (c), 0, 0, 0)
DI float max3f(float a, float b, float c) { float r; asm("v_max3_f32 %0, %1, %2, %3" : "=v"(r) : "v"(a), "v"(b), "v"(c)); return r; }
DI int crow(int i, int hh) { return (i & 3) + 8 * (i >> 2) + 4 * hh; }
#define ATT_WAIT_V(n) asm volatile("s_waitcnt vmcnt(" #n ")" ::: "memory")

template <int MODE>
DI void attn_issue(const char* ktile, const char* vtile, int tid, LAS unsigned char* stage, int w) {
    using C = AttnCfg<MODE>;
    asm volatile("" : "+v"(tid));
    const int krow_s = tid / C::PPR, kpc_s = tid % C::PPR;
    const int kswz_s = (C::PPR == 16) ? (krow_s & 15) : ((krow_s >> 1) & 7);
    const unsigned koff = (unsigned)(krow_s * C::KW * 2 + ((kpc_s ^ kswz_s) << 4));
    const int vrow_s = tid >> 3, vpc_s = tid & 7;
    const unsigned voff = (unsigned)(vrow_s * T * 2 + ((vpc_s ^ ((vrow_s >> 1) & 7)) << 4));
#pragma unroll
    for (int i = 0; i < C::NIK; ++i)
        __builtin_amdgcn_global_load_lds((const unsigned*)(ktile + (koff + (unsigned)(i * (512 / C::PPR) * C::KW * 2))), (LAS unsigned*)(stage + i * 8192 + w * 1024), 16, 0, 0);
#pragma unroll
    for (int i = 0; i < C::NIV; ++i)
        __builtin_amdgcn_global_load_lds((const unsigned*)(vtile + (voff + (unsigned)(i * 64 * T * 2))), (LAS unsigned*)(stage + C::KT_BYTES + i * 8192 + w * 1024), 16, 0, 0);
}

template <int MODE>
DI void attn_phase(LAS unsigned char* lds, const bf16_t* Q, const bf16_t* Kb, const bf16_t* Vt, bf16_t* O,
                   const float* lamp, const float* subln, float lam_init, const float* rpb, const float* sink, const int tid, const int bid) {
    using C = AttnCfg<MODE>;
    constexpr int NC = C::NC, NDT = C::NDT;
    const int w = __builtin_amdgcn_readfirstlane(tid >> 6);
    const int G = gridDim.x;
    constexpr int nlat = C::NH * 64, ntotal = nlat + C::NH;
    LAS float* rpbL = (LAS float*)(lds + C::NSTG * C::STAGE);
    float lam_full = 0.f;
    if (MODE == 0) { const int lane = tid & 63; float p0 = lamp[lane] * lamp[64 + lane], p1 = lamp[128 + lane] * lamp[192 + lane]; p0 = wave_sum(p0, lane); p1 = wave_sum(p1, lane); lam_full = expf(p0) - expf(p1) + lam_init; lam_full = __builtin_bit_cast(float, __builtin_amdgcn_readfirstlane(__builtin_bit_cast(int, lam_full))); }
    lam_init = __builtin_bit_cast(float, __builtin_amdgcn_readfirstlane(__builtin_bit_cast(int, lam_init)));

    for (int u = bid; u < ntotal; u += G) {
        int tidu = tid; asm volatile("" : "+v"(tidu));
        const int lane = tidu & 63, r = lane & 31, hh = lane >> 5;
        const int ky = hh ^ ((C::PPR == 16) ? (r & 15) : ((r >> 1) & 7));
        const int vy = hh ^ ((r >> 1) & 7);
        const unsigned krb = (unsigned)(r * C::RB), vrb = (unsigned)(C::KT_BYTES + r * 128);
        const bool isctx = u >= nlat;
        const int head = isctx ? u - nlat : (u & (C::NH - 1));
        const int qb = isctx ? 0 : u / C::NH;
        const int tq = (isctx ? 0 : NCTX + 256 * qb) + 32 * w + r;
        const int qcol = MODE == 0 ? head * 128 : head * 64;
        const int kcol = MODE == 0 ? head * 128 : (MODE == 1 ? head * 64 : (head >> 2) * 64);
        const int vrow = kcol;
        int ntile = 4, b_lo = 0;
        if (!isctx) {
            if (MODE == 0) ntile = T / 64;
            else if (MODE == 2) { const int plo = (256 * qb - 128) < 0 ? 0 : 256 * qb - 128, phi = (256 * qb + 384) > SEQ ? SEQ : 256 * qb + 384; b_lo = plo; ntile = 4 + (phi - plo) / 64; }
            else { int rlo = 4 * qb - 4; rlo = rlo < 0 ? 0 : (rlo > 248 ? 248 : rlo); int rhi = 4 * qb - 1; rhi = rhi < 0 ? 0 : (rhi > 248 ? 248 : rhi); rhi += 8; b_lo = rlo; ntile = 4 + (rhi - rlo); }
        }
#define TOK0(it) (MODE == 0 ? 64 * (it) : ((it) < 4 ? 64 * (it) : (MODE == 2 ? NCTX + b_lo + 64 * ((it) - 4) : NCTX + 64 * (b_lo + (it) - 4))))
        bf16x8 qf[NC][4];
#pragma unroll
        for (int mc = 0; mc < NC; ++mc)
#pragma unroll
            for (int ks = 0; ks < 4; ++ks) qf[mc][ks] = *(const bf16x8*)(Q + (size_t)tq * D + qcol + 64 * mc + 16 * ks + 8 * hh);
        LAS unsigned char* qpark = lds + C::NSTG * C::STAGE + w * 4096 + lane * 16;
        if (MODE == 0) {
#pragma unroll
            for (int ks = 0; ks < 4; ++ks) *(LAS bf16x8*)(qpark + ks * 1024) = qf[NC - 1][ks];
        }
        if (MODE == 1) { if (tid < 465) rpbL[tid] = rpb[head * 465 + tid] * LOG2E; }

        f32x16 Oa[NC][NDT];
#pragma unroll
        for (int mc = 0; mc < NC; ++mc)
#pragma unroll
            for (int dt = 0; dt < NDT; ++dt)
#pragma unroll
                for (int i = 0; i < 16; ++i) Oa[mc][dt][i] = 0.f;
        float mrun[NC], lrun[NC];
#pragma unroll
        for (int mc = 0; mc < NC; ++mc) { mrun[mc] = -1e30f; lrun[mc] = 0.f; }

        const char* kb0 = (const char*)(Kb + kcol); const char* vb0 = (const char*)(Vt + (size_t)vrow * T);
        asm volatile("s_waitcnt vmcnt(0) lgkmcnt(0)" ::: "memory");
        { int tk = TOK0(0); asm volatile("" : "+s"(tk)); attn_issue<MODE>(kb0 + (size_t)tk * C::KW * 2, vb0 + (size_t)tk * 2, tid, lds, w); }
        if (ntile > 1) { int tk = TOK0(1); asm volatile("" : "+s"(tk)); attn_issue<MODE>(kb0 + (size_t)tk * C::KW * 2, vb0 + (size_t)tk * 2, tid, lds + C::STAGE, w); }

        const int qpl = 256 * qb + 32 * w + r;
        const int qw0 = 256 * qb + 32 * w;
        const int qr = qpl >> 6, qc = qpl & 63;
        int kr0 = qr - 4; kr0 = kr0 < 0 ? 0 : (kr0 > 248 ? 248 : kr0);
        int kc0 = qc - 8; kc0 = kc0 < 0 ? 0 : (kc0 > 48 ? 48 : kc0);

        int stg = 0;
        for (int it = 0; it < ntile; ++it) {
            if (it + 1 < ntile) { if (C::NL == 4) ATT_WAIT_V(4); else ATT_WAIT_V(2); } else ATT_WAIT_V(0);
            __builtin_amdgcn_s_barrier();
            const int s2 = stg == 0 ? 2 : stg - 1;
            LAS unsigned char* sb = lds + stg * C::STAGE;
            stg = stg == 2 ? 0 : stg + 1;
            const bool masked = (MODE != 0) && !isctx && it >= 4;
            bool tile_on = true; int kp0 = 0, krow_t = 0;
            if (MODE == 2 && masked) { kp0 = b_lo + 64 * (it - 4); tile_on = !(kp0 > qw0 + 31 + 128 || kp0 + 63 < qw0 - 128); }
            if (MODE == 1 && masked) { krow_t = b_lo + (it - 4); tile_on = (krow_t >= kr0) && (krow_t < kr0 + 8); }
            tile_on = __builtin_amdgcn_readfirstlane(tile_on ? 1 : 0) != 0;
            bf16x8 kf[NC][4], vf[2][NDT];
#define LOAD_KF(t_, mc) do { _Pragma("unroll") for (int ks = 0; ks < 4; ++ks) \
                kf[mc][ks] = *(const LAS bf16x8*)(sb + (krb + (unsigned)((t_) * 32 * C::RB)) + (unsigned)(((8 * (mc) + 2 * ks) ^ ky) << 4)); } while (0)
#define LOAD_VF(t_) do { _Pragma("unroll") for (int s = 0; s < 2; ++s) _Pragma("unroll") for (int dt = 0; dt < NDT; ++dt) \
                vf[s][dt] = *(const LAS bf16x8*)(sb + (vrb + (unsigned)(dt * 32 * 128)) + (unsigned)(((4 * (t_) + 2 * s) ^ vy) << 4)); } while (0)
            LOAD_KF(0, 0);
#pragma unroll
            for (int t = 0; t < 2; ++t) {
                bool sub_on = tile_on;
                if (MODE == 2 && masked) { const int ks0 = kp0 + 32 * t; sub_on = sub_on && !(ks0 > qw0 + 31 + 128 || ks0 + 31 < qw0 - 128); }
                bf16x8 P[NC][2];
                f32x16 S[NC];
                __builtin_amdgcn_sched_barrier(0);
                if (sub_on) {
                    bf16x8 qp[4];
                    if (MODE == 0) {
                        LOAD_KF(t, NC - 1);
#pragma unroll
                        for (int ks = 0; ks < 4; ++ks) qp[ks] = *(const LAS bf16x8*)(qpark + ks * 1024);
                    }
#pragma unroll
                    for (int mc = 0; mc < NC; ++mc) {
#pragma unroll
                        for (int i = 0; i < 16; ++i) S[mc][i] = 0.f;
#pragma unroll
                        for (int ks = 0; ks < 4; ++ks) S[mc] = MFMA32(kf[mc][ks], (MODE == 0 && mc == 1) ? qp[ks] : qf[0][ks], S[mc]);
                    }
                }
                __builtin_amdgcn_sched_barrier(0);
                LOAD_VF(t);
                if (sub_on) {
                    float mxv[NC];
#pragma unroll
                    for (int mc = 0; mc < NC; ++mc) {
                        if (MODE == 2 && masked && !(kp0 + 32 * t >= qw0 + 31 - 128 && kp0 + 32 * t + 31 <= qw0 + 128)) {
#pragma unroll
                            for (int i = 0; i < 16; ++i) { const int kp = kp0 + 32 * t + crow(i, hh); const int dd = qpl - kp; const bool ok = (dd <= 128) && (dd >= -128); S[mc][i] = ok ? S[mc][i] : -1e30f; }
                        }
                        if (MODE == 1 && masked) {
                            const LAS float* pb = rpbL + ((krow_t - qr + 7) * 31 + 15 - qc + 4 * hh);
#pragma unroll
                            for (int i = 0; i < 16; ++i) { const int kcl = 32 * t + (i & 3) + 8 * (i >> 2); const bool ok = (unsigned)(kcl + 4 * hh - kc0) < 16u;
                                const float bv = pb[kcl]; S[mc][i] = ok ? S[mc][i] + bv : -1e30f; }
                        }
                        float mx = fmaxf(S[mc][0], S[mc][1]);
#pragma unroll
                        for (int i = 2; i < 16; i += 2) mx = max3f(mx, S[mc][i], S[mc][i + 1]);
                        mxv[mc] = mx;
                    }
#pragma unroll
                    for (int mc = 0; mc < NC; ++mc) {
                        const float mx = xhalf_max(mxv[mc]);
                        if (__any(mx > mrun[mc] + 6.f)) {
                            const float mn = fmaxf(mrun[mc], mx); const float al = __builtin_amdgcn_exp2f(mrun[mc] - mn); mrun[mc] = mn; lrun[mc] *= al;
#pragma unroll
                            for (int dt = 0; dt < NDT; ++dt)
#pragma unroll
                                for (int i = 0; i < 16; ++i) Oa[mc][dt][i] *= al;
                        }
                    }
                }
                __builtin_amdgcn_sched_barrier(0);
#define SM_EXP(mc) do { const f32x2 m2 = {mrun[mc], mrun[mc]}; f32x2 ps2 = {0.f, 0.f}; unsigned pk[8]; \
                    _Pragma("unroll") for (int i = 0; i < 8; ++i) { f32x2 d = {S[mc][2 * i], S[mc][2 * i + 1]}; d = d - m2; f32x2 e; e.x = __builtin_amdgcn_exp2f(d.x); e.y = __builtin_amdgcn_exp2f(d.y); ps2 += e; pk[i] = cvtpk(e.x, e.y); } \
                    lrun[mc] += ps2.x + ps2.y; \
                    _Pragma("unroll") for (int s = 0; s < 2; ++s) { u32x4 q4; q4.x = pk[4 * s]; q4.y = pk[4 * s + 1]; q4.z = pk[4 * s + 2]; q4.w = pk[4 * s + 3]; P[mc][s] = __builtin_bit_cast(bf16x8, q4); } } while (0)
#define PV_MM(mc) do { _Pragma("unroll") for (int s = 0; s < 2; ++s) _Pragma("unroll") for (int dt = 0; dt < NDT; ++dt) Oa[mc][dt] = MFMA32(vf[s][dt], P[mc][s], Oa[mc][dt]); } while (0)
                if (sub_on) {
                    SM_EXP(0);
                    __builtin_amdgcn_sched_barrier(0);
                    if (NC == 2) {
                        PV_MM(0);
                        SM_EXP(NC - 1);
#pragma unroll
                        for (int g = 0; g < 2 * NDT; ++g) { __builtin_amdgcn_sched_group_barrier(0x008, 1, 0); __builtin_amdgcn_sched_group_barrier(0x002, 4, 0); __builtin_amdgcn_sched_group_barrier(0x400, 2, 0); }
                        __builtin_amdgcn_sched_barrier(0);
                        if (t == 0) LOAD_KF(1, 0);
                        PV_MM(NC - 1);
                    } else {
                        if (t == 0) LOAD_KF(1, 0);
                        PV_MM(0);
                    }
                } else { if (t == 0) LOAD_KF(1, 0); }
                __builtin_amdgcn_sched_barrier(0);
            }
            if (it + 2 < ntile) { int tk = TOK0(it + 2); asm volatile("" : "+s"(tk));
                attn_issue<MODE>(kb0 + (size_t)tk * C::KW * 2, vb0 + (size_t)tk * 2, tid, lds + s2 * C::STAGE, w); }
#undef SM_EXP
#undef PV_MM
#undef LOAD_KF
#undef LOAD_VF
        }
        __builtin_amdgcn_s_barrier();
        int tid3 = tid; asm volatile("" : "+v"(tid3));
        const int tq3 = (isctx ? 0 : NCTX + 256 * qb) + (tid3 >> 6) * 32 + (tid3 & 31);
        bf16_t* orow = O + (size_t)tq3 * D + qcol;
        if (MODE == 0) {
            const float l0 = lrun[0] + shfl_xor_l(lrun[0], 32, lane), l1 = lrun[NC - 1] + shfl_xor_l(lrun[NC - 1], 32, lane);
            const float i0 = 1.f / l0, i1 = lam_full / l1; float ss = 0.f;
#pragma unroll
            for (int dt = 0; dt < NDT; ++dt)
#pragma unroll
                for (int i = 0; i < 16; ++i) { const float o = Oa[0][dt][i] * i0 - Oa[NC - 1][dt][i] * i1; Oa[0][dt][i] = o; ss += o * o; }
            ss += shfl_xor_l(ss, 32, lane);
            float li_ = lam_init; asm volatile("" : "+s"(li_));
            const float rn = (1.f / sqrtf(ss * (1.f / 128.f) + NORM_EPS)) * (1.f - li_);
#pragma unroll
            for (int dt = 0; dt < NDT; ++dt)
#pragma unroll
                for (int g = 0; g < 4; ++g) { const int dvb = 32 * dt + 8 * g + 4 * hh; const f32x4 sg = *(const f32x4*)(subln + dvb);
                    u32x2 wv; wv.x = cvtpk(Oa[0][dt][4 * g] * rn * sg[0], Oa[0][dt][4 * g + 1] * rn * sg[1]); wv.y = cvtpk(Oa[0][dt][4 * g + 2] * rn * sg[2], Oa[0][dt][4 * g + 3] * rn * sg[3]);
                    *(u32x2*)(orow + dvb) = wv; }
        } else {
            float lt = lrun[0] + shfl_xor_l(lrun[0], 32, lane); float inv;
            if (MODE == 2) { const float s2 = sink[head] * LOG2E; const float mf = fmaxf(mrun[0], s2); const float al = __builtin_amdgcn_exp2f(mrun[0] - mf); lt = lt * al + __builtin_amdgcn_exp2f(s2 - mf); inv = al / lt; }
            else inv = 1.f / lt;
#pragma unroll
            for (int dt = 0; dt < NDT; ++dt)
#pragma unroll
                for (int g = 0; g < 4; ++g) { const int dvb = 32 * dt + 8 * g + 4 * hh;
                    u32x2 wv; wv.x = cvtpk(Oa[0][dt][4 * g] * inv, Oa[0][dt][4 * g + 1] * inv); wv.y = cvtpk(Oa[0][dt][4 * g + 2] * inv, Oa[0][dt][4 * g + 3] * inv);
                    *(u32x2*)(orow + dvb) = wv; }
        }
#undef TOK0
    }
}

#define XB_TMO      128
#define XB_XCNT(j)  (256  + 64 * (j))
#define XB_XSUB(j)  (1280 + 64 * (j))
#define XB_XGEN(j)  (2304 + 64 * (j))
#define XB_TOP      3328
#define XB_TOPGEN   3392
#define XCD_BAR_WORDS 3456
#define XB_SPIN_CAP (1u << 18)

__device__ __forceinline__ unsigned xb_ld(unsigned* p)              { return __hip_atomic_load(p, __ATOMIC_RELAXED, __HIP_MEMORY_SCOPE_AGENT); }
__device__ __forceinline__ unsigned xb_add(unsigned* p, unsigned v) { return __hip_atomic_fetch_add(p, v, __ATOMIC_RELAXED, __HIP_MEMORY_SCOPE_AGENT); }
__device__ __forceinline__ unsigned xb_xcc_id() { return (unsigned)__builtin_amdgcn_s_getreg((3 << 11) | 20) & 0xFu; }
#define XB_SPIN(cond, bar) do { unsigned _sp = 0; while (cond) { __builtin_amdgcn_s_sleep(1); \
    if ((++_sp & 255u) == 0u) { if (xb_ld(&(bar)[XB_TMO])) break; if (_sp > XB_SPIN_CAP) { atomicAdd(&(bar)[XB_TMO], 1u); break; } } } } while (0)

struct XcdBarrier {
    unsigned* bar; unsigned x;
    volatile LAS unsigned* st;
};

__device__ __forceinline__ XcdBarrier xcd_barrier_post(unsigned* bar, volatile LAS unsigned* st) {
    XcdBarrier b; b.bar = bar; b.x = xb_xcc_id(); b.st = st;
    if (threadIdx.x == 0) (void)xb_add(&bar[XB_XCNT(b.x)], 1u);
    return b;
}
__device__ __forceinline__ void xcd_barrier_complete(unsigned* bar, unsigned x, unsigned& nloc, unsigned& nx) {
    const unsigned G = gridDim.x * gridDim.y * gridDim.z;
    unsigned sum, cnt, mine, sp = 0u;
    for (;;) {
        sum = 0u; cnt = 0u; mine = 0u;
#pragma unroll
        for (unsigned j = 0; j < 16; ++j) { const unsigned c = xb_ld(&bar[XB_XCNT(j)]); sum += c; cnt += (c > 0u) ? 1u : 0u; mine = (j == x) ? c : mine; }
        if (sum == G) break;
        __builtin_amdgcn_s_sleep(1);
        if ((++sp & 255u) == 0u) { if (xb_ld(&bar[XB_TMO])) break; if (sp > XB_SPIN_CAP) { atomicAdd(&bar[XB_TMO], 1u); break; } }
    }
    nloc = mine > 0u ? mine : 1u; nx = cnt > 0u ? cnt : 1u;
}

__device__ __forceinline__ void xcd_barrier(const XcdBarrier& b) {
    asm volatile("s_waitcnt vmcnt(0)" ::: "memory");
    __syncthreads();
    if (threadIdx.x == 0) {
        unsigned* bar = b.bar;
        __builtin_amdgcn_s_waitcnt(0);
        unsigned nloc = b.st[0], nx = b.st[1];
        if (nloc == 0u) { xcd_barrier_complete(bar, b.x, nloc, nx); b.st[0] = nloc; b.st[1] = nx; }
        const unsigned old = xb_add(&bar[XB_XSUB(b.x)], 1u);
        const unsigned gen = old / nloc;
        if (old + 1u == (gen + 1u) * nloc) {
            __builtin_amdgcn_fence(__ATOMIC_RELEASE, "agent");
            asm volatile("s_waitcnt vmcnt(0)" ::: "memory");
            const unsigned og = xb_add(&bar[XB_TOP], 1u);
            const unsigned tg = og / nx;
            if (og + 1u == (tg + 1u) * nx) xb_add(&bar[XB_TOPGEN], 1u);
            else XB_SPIN(xb_ld(&bar[XB_TOPGEN]) == tg, bar);
            __builtin_amdgcn_fence(__ATOMIC_ACQUIRE, "agent");
            xb_add(&bar[XB_XGEN(b.x)], 1u);
            asm volatile("s_waitcnt vmcnt(0)" ::: "memory");
        } else {
            XB_SPIN(xb_ld(&bar[XB_XGEN(b.x)]) == gen, bar);
            __builtin_amdgcn_fence(__ATOMIC_ACQUIRE, "agent");
            asm volatile("s_waitcnt vmcnt(0)" ::: "memory");
        }
    }
    __syncthreads();
}

constexpr int LDS_BAR_OFF = 131072 + 64;
constexpr int LDS_BYTES = 135168;
constexpr int N_PHASES = 2 + 7 * DEPTH;

__global__ void __launch_bounds__(512) fwd_megakernel(Args a) {
    extern __shared__ __attribute__((aligned(16))) unsigned char lds_raw[];
    LAS unsigned char* lds = (LAS unsigned char*)lds_raw;
    cg::grid_group grid = cg::this_grid();
    const int G = gridDim.x;
    const int wave_id_ = __builtin_amdgcn_readfirstlane((int)threadIdx.x >> 6);
    volatile LAS unsigned* bar_st = (volatile LAS unsigned*)(lds + LDS_BAR_OFF);
    if (threadIdx.x < 2) bar_st[threadIdx.x] = 0u;
    __syncthreads();
    if (blockIdx.x == 0) { unsigned* bw = (unsigned*)(a.ws + WS_BAR); for (int i = threadIdx.x; i < XCD_BAR_WORDS; i += 512) bw[i] = 0u; }
    XcdBarrier xbar; xbar.bar = (unsigned*)(a.ws + WS_BAR); xbar.x = 0u; xbar.st = bar_st;
    bf16_t* H = (bf16_t*)(a.ws + WS_H); bf16_t* Qb = (bf16_t*)(a.ws + WS_Q); bf16_t* Kb = (bf16_t*)(a.ws + WS_K); bf16_t* Vt = (bf16_t*)(a.ws + WS_VT);
    bf16_t* ACT = (bf16_t*)(a.ws + WS_ACT); bf16_t* Y = (bf16_t*)(a.ws + WS_Y);
    for (int ph = a.ph_lo; ph < a.ph_hi; ++ph) {
        unsigned ones_ = ~0u; asm volatile("" : "+s"(ones_));
        int tid = wave_id_ * 64 + (int)__builtin_amdgcn_mbcnt_hi(ones_, __builtin_amdgcn_mbcnt_lo(ones_, 0u)); asm volatile("" : "+v"(tid));
        int c = blockIdx.x; asm volatile("" : "+s"(c));
        if (ph == 0) phase_p0(a, lds, tid, c);
        else if (ph == 1) rowpass<0>(a, 0, tid, c);
        else {
            const int li = (ph - 2) / 7, sub = (ph - 2) % 7, mixer = li % 3, j = li / 3;
            const bf16_t* wt = (const bf16_t*)(a.ws + WS_WT) + (size_t)li * LWT;
            if (sub == 0) {
                const int kw = mixer == 2 ? 256 : 1024;
                MSched S; S.init(H, wt + WT_QKV, T / 256, (1024 + kw) / 256, wt + WT_QKV + (size_t)(1024 + kw) * 1024, H, kw / 256, T / 256, 1024, G, c);
                EpiQKV E{Qb, Kb, Vt, kw, mixer != 1 ? 1 : 0};
                pg8::gemm_phase<EpiQKV, MSched, true, true>(lds, 1024, 1024, S, E, tid);
            } else if (sub == 1) {
                if (mixer == 0) attn_phase<0>(lds, Qb, Kb, Vt, H, a.in[11] + j * 256, a.in[12] + j * 128, 0.8f - 0.6f * expf(-0.3f * (float)li), nullptr, nullptr, tid, c);
                else if (mixer == 1) attn_phase<1>(lds, Qb, Kb, Vt, H, nullptr, nullptr, 0.f, a.in[15], nullptr, tid, c);
                else attn_phase<2>(lds, Qb, Kb, Vt, H, nullptr, nullptr, 0.f, nullptr, a.in[18], tid, c);
            } else if (sub == 2) {
                { KSched S{H, wt + WT_O, 4, 1024, G, c}; EpiYP E{(float*)(a.ws + WS_YP)};
                  pg8::gemm_phase<EpiYP, KSched, true, true>(lds, 256, 1024, S, E, tid); }
                MSched S; S.init(H + (size_t)NCTX * 1024, wt + WT_O, SEQ / 256, 4, nullptr, nullptr, 0, 0, 1024, G, c);
                EpiY E{Y + (size_t)NCTX * D};
                pg8::gemm_phase<EpiY, MSched, true, true>(lds, 1024, 1024, S, E, tid);
            } else if (sub == 3) rowpass<1>(a, li, tid, c);
            else if (sub == 4) {
                MSched S; S.init(H, wt + WT_13, T / 256, FF2 / 256, nullptr, nullptr, 0, 0, 1024, G, c);
                EpiSwi E{ACT};
                pg8::gemm_phase<EpiSwi, MSched, true, true>(lds, 1024, 1024, S, E, tid);
            } else if (sub == 5) {
                { KSched S{ACT, wt + WT_2, 11, FF, G, c}; EpiYP E{(float*)(a.ws + WS_YP)};
                  pg8::gemm_phase<EpiYP, KSched, true, true>(lds, 256, FF, S, E, tid); }
                MSched S; S.init(ACT + (size_t)NCTX * FF, wt + WT_2, SEQ / 256, 4, nullptr, nullptr, 0, 0, FF, G, c);
                EpiY E{Y + (size_t)NCTX * D};
                pg8::gemm_phase<EpiY, MSched, true, true>(lds, FF, FF, S, E, tid);
            } else rowpass<2>(a, li, tid, c);
        }
        if (ph + 1 < a.ph_hi) { if (ph == a.ph_lo) { grid.sync(); xbar = xcd_barrier_post((unsigned*)(a.ws + WS_BAR), bar_st); } else xcd_barrier(xbar); }
    }
}

extern "C" void kernel_launch(void* const* d_in, const int* in_sizes, int n_in, void* d_out, int out_size, void* d_ws, size_t ws_size, hipStream_t stream) {
    static int grid = 0;
    if (grid == 0) {
        if (n_in != 19 || out_size != SEQ * D || ws_size < WS_END) { fprintf(stderr, "kernel_launch: unexpected shapes (n_in %d, out %d, ws %zu)\n", n_in, out_size, ws_size); grid = -1; return; }
        int dev = 0, cus = 0, per_cu = 0;
        (void)hipGetDevice(&dev);
        (void)hipDeviceGetAttribute(&cus, hipDeviceAttributeMultiprocessorCount, dev);
        (void)hipFuncSetAttribute((const void*)fwd_megakernel, hipFuncAttributeMaxDynamicSharedMemorySize, LDS_BYTES);
        (void)hipOccupancyMaxActiveBlocksPerMultiprocessor(&per_cu, (const void*)fwd_megakernel, 512, LDS_BYTES);
        if (per_cu < 1) per_cu = 1;
        grid = cus * per_cu;
        (void)hipGetLastError();
    }
    if (grid < 0) return;
    Args a{};
    for (int i = 0; i < 19; ++i) a.in[i] = (const float*)d_in[i];
    a.out = (float*)d_out; a.ws = (unsigned char*)d_ws; a.ph_lo = 0; a.ph_hi = N_PHASES;
    void* args[] = {&a};
    hipError_t e = hipLaunchCooperativeKernel((const void*)fwd_megakernel, dim3(grid), dim3(512), args, LDS_BYTES, stream);
    if (e != hipSuccess) fprintf(stderr, "cooperative launch failed: %s (grid %d)\n", hipGetErrorString(e), grid);
}
```
